# Optimizing an MI355X kernel written in HIP

```python
import jax, jax.numpy as jnp
from jax import lax
import numpy as np

D_MODEL = 2048
BATCH = 32
SEQ = 256
DEPTH = 2
DEC_BATCH = 2
DEC_SEQ = 2048
PAST_LEN = 256

GRID_W = 64
NA_HEADS = 8
NA_HEAD_DIM = 128
NA_WIDTH = NA_HEADS * NA_HEAD_DIM
NA_WIN_H = 8
NA_WIN_W = 16
NA_QCOLS = 8
NA_KCOLS = NA_WIN_W + NA_QCOLS
GLA_HEADS = 4
GLA_DK = 128
GLA_DV = 256
GLA_KW = GLA_HEADS * GLA_DK
GLA_VW = GLA_HEADS * GLA_DV
GLA_LOWRANK = 16
GLA_TAU = 16.0
GLA_CHUNK = 64
ROPE_BASE = 10000.0
CONV_WIDTH = 1024
CONV_TAPS = 31
ALPHA = (2 * DEPTH) ** 0.25
BETA = (8 * DEPTH) ** -0.25
LN_EPS = 1e-5
NEG_INF = -1e30
SPLIT_SIZES = (NA_WIDTH, NA_WIDTH, NA_WIDTH, NA_WIDTH,
               GLA_KW, GLA_KW, GLA_VW, 2 * GLA_LOWRANK, GLA_VW,
               CONV_WIDTH, CONV_WIDTH, CONV_WIDTH,
               D_MODEL, D_MODEL, D_MODEL)
N_IN = sum(SPLIT_SIZES)

kernel_name = 'hybrid_natten_gla_conformer_dit_step'


def layer_norm(x, g=None, b=None):
    xf = x.astype(jnp.float32)
    mu = jnp.mean(xf, -1, keepdims=True)
    var = jnp.mean(jnp.square(xf - mu), -1, keepdims=True)
    y = (xf - mu) * lax.rsqrt(var + LN_EPS)
    if g is not None:
        y = y * g + b
    return y.astype(x.dtype)


def split_cols(p):
    offs = np.cumsum(SPLIT_SIZES)[:-1].tolist()
    return jnp.split(p, offs, axis=-1)


def axial_rope(x):
    seq_len, dk = x.shape[1], x.shape[-1]
    t = jnp.arange(seq_len)
    half = dk // 2
    inv = ROPE_BASE ** (-jnp.arange(0, half, 2, dtype=jnp.float32) / half)

    def rot(xa, pos):
        ang = pos.astype(jnp.float32)[:, None] * inv[None, :]
        cos = jnp.cos(ang)[None, :, None, :]
        sin = jnp.sin(ang)[None, :, None, :]
        x1, x2 = xa[..., :half // 2], xa[..., half // 2:]
        return jnp.concatenate([x1 * cos - x2 * sin, x1 * sin + x2 * cos], -1)

    out = jnp.concatenate([rot(x[..., :half], t // GRID_W), rot(x[..., half:], t % GRID_W)], -1)
    return out.astype(x.dtype)


def context_attention(q, k, v):
    bsz, seq_len, nh, hd = q.shape
    s = jnp.einsum('bqhd,bkhd->bhqk', q, k, preferred_element_type=jnp.float32) * hd ** -0.5
    p = jax.nn.softmax(s, axis=-1).astype(v.dtype)
    return jnp.einsum('bhqk,bkhd->bqhd', p, v).reshape(bsz, seq_len, nh * hd)


def na_index_tables(rows):
    kh = min(NA_WIN_H, rows)
    ncb = GRID_W // NA_QCOLS
    r = np.arange(rows)
    rs = np.clip(r - kh // 2, 0, rows - kh)
    c = np.arange(GRID_W)
    cs = np.clip(c - NA_WIN_W // 2, 0, GRID_W - NA_WIN_W)
    j = np.arange(ncb)
    bs = np.clip(j * NA_QCOLS - NA_WIN_W // 2, 0, GRID_W - NA_KCOLS)
    key_row = rs[:, None] + np.arange(kh)[None, :]
    key_col = bs[:, None] + np.arange(NA_KCOLS)[None, :]
    key_idx = key_row[:, None, :, None] * GRID_W + key_col[None, :, None, :]
    qcol = j[:, None] * NA_QCOLS + np.arange(NA_QCOLS)[None, :]
    dr = key_row - r[:, None]
    dc = key_col[:, None, :] - qcol[:, :, None]
    start = cs[qcol][:, :, None]
    valid = (key_col[:, None, :] >= start) & (key_col[:, None, :] < start + NA_WIN_W)
    full = (rows, ncb, NA_QCOLS, kh, NA_KCOLS)
    kk = kh * NA_KCOLS
    dr_idx = np.broadcast_to(dr[:, None, None, :, None], full).reshape(rows, ncb, NA_QCOLS, kk) + (NA_WIN_H - 1)
    dc_idx = np.clip(np.broadcast_to(dc[None, :, :, None, :], full).reshape(rows, ncb, NA_QCOLS, kk) + (NA_WIN_W - 1), 0, 2 * NA_WIN_W - 2)
    valid = np.broadcast_to(valid[None, :, :, None, :], full).reshape(rows, ncb, NA_QCOLS, kk)
    return key_idx.reshape(rows, ncb, kk), dr_idx, dc_idx, valid


def neighbourhood_attention(q, k, v, k_ctx, v_ctx, rpb):
    bsz, n_tok, nh, hd = q.shape
    rows = n_tok // GRID_W
    ncb = GRID_W // NA_QCOLS
    key_idx, dr_idx, dc_idx, valid = na_index_tables(rows)
    bias = jnp.where(valid, rpb[:, dr_idx, dc_idx].astype(jnp.float32), NEG_INF)
    bias = jnp.moveaxis(bias, 1, 0)
    qb = jnp.moveaxis(q.reshape(bsz, rows, ncb, NA_QCOLS, nh, hd), 1, 0)
    scale = hd ** -0.5
    n_win = key_idx.shape[-1]

    def row_block(inp):
        q_r, idx_r, bias_r = inp
        k_r = jnp.take(k, idx_r, axis=1)
        v_r = jnp.take(v, idx_r, axis=1)
        s_win = jnp.einsum('bnqhd,bnkhd->bhnqk', q_r, k_r, preferred_element_type=jnp.float32) * scale + bias_r
        s_ctx = jnp.einsum('bnqhd,bphd->bhnqp', q_r, k_ctx, preferred_element_type=jnp.float32) * scale
        p = jax.nn.softmax(jnp.concatenate([s_win, s_ctx], -1), axis=-1)
        return (jnp.einsum('bhnqk,bnkhd->bnqhd', p[..., :n_win].astype(v.dtype), v_r)
                + jnp.einsum('bhnqp,bphd->bnqhd', p[..., n_win:].astype(v.dtype), v_ctx))

    o = lax.map(row_block, (qb, jnp.asarray(key_idx, jnp.int32), bias))
    return jnp.moveaxis(o, 0, 1).reshape(bsz, n_tok, nh * hd)


def gla_chunk_scan(q, k, v, log_a, s0):
    bsz, seq_len, nh, dk = q.shape
    dv = v.shape[-1]
    n_chunks = seq_len // GLA_CHUNK
    chunk = lambda t: t.reshape(bsz, n_chunks, GLA_CHUNK, nh, t.shape[-1])
    q, k, v, log_a = chunk(q), chunk(k), chunk(v), chunk(log_a)
    b = jnp.cumsum(log_a, axis=2)
    b_last = b[:, :, -1:]
    q_e = q * jnp.exp(b)
    k_e = k * jnp.exp(-b)
    causal = jnp.tril(jnp.ones((GLA_CHUNK, GLA_CHUNK), bool))
    att = jnp.where(causal, jnp.einsum('bnihd,bnjhd->bnhij', q_e, k_e), 0.0)
    o_intra = jnp.einsum('bnhij,bnjhe->bnihe', att, v)
    kv = jnp.einsum('bnjhd,bnjhe->bnhde', k * jnp.exp(b_last - b), v)
    decay = jnp.exp(b_last[:, :, 0])

    def step(s, inp):
        dec, kv_n = inp
        return dec[..., None] * s + kv_n, s

    s_final, s_before = lax.scan(step, s0, (jnp.moveaxis(decay, 1, 0), jnp.moveaxis(kv, 1, 0)))
    o_inter = jnp.einsum('bnihd,bnhde->bnihe', q_e, jnp.moveaxis(s_before, 0, 1))
    return (o_intra + o_inter).reshape(bsz, seq_len, nh, dv), s_final


def gla_bidir(q, k, v, la_f, la_b, s0_f, s0_b):
    o_f, s_f = gla_chunk_scan(q, k, v, la_f, s0_f)
    flip = lambda t: t[:, ::-1]
    o_b, s_b = gla_chunk_scan(flip(q), flip(k), flip(v), flip(la_b), s0_b)
    diag = jnp.einsum('blhd,blhd->blh', q, k)[..., None] * v
    return o_f + flip(o_b) - diag, s_f, s_b


def gla_branch(b_q, b_k, b_v, b_lr, w_gate, b_gate, norm_g, s0, latent):
    bsz, seq_len = b_q.shape[:2]
    hs = lambda t, d: t.reshape(bsz, seq_len, GLA_HEADS, d).astype(jnp.float32)
    q = hs(b_q, GLA_DK) * GLA_DK ** -0.5
    k = hs(b_k, GLA_DK)
    v = hs(b_v, GLA_DV)
    if latent:
        q, k = axial_rope(q), axial_rope(k)
    lr = b_lr.astype(jnp.float32).reshape(bsz, seq_len, 2, GLA_LOWRANK)
    gate_pre = jnp.einsum('blzr,zrk->blzk', lr, w_gate.astype(jnp.float32)) + b_gate.astype(jnp.float32)
    la = (jax.nn.log_sigmoid(gate_pre) / GLA_TAU).reshape(bsz, seq_len, 2, GLA_HEADS, GLA_DK)
    o, s_f, s_b = gla_bidir(q, k, v, la[:, :, 0], la[:, :, 1], s0[:, 0], s0[:, 1])
    o = o * lax.rsqrt(jnp.mean(o * o, -1, keepdims=True) + LN_EPS) * norm_g.astype(jnp.float32).reshape(GLA_HEADS, GLA_DV)
    return o.reshape(bsz, seq_len, GLA_VW), jnp.stack([s_f, s_b], axis=1)


def conformer_conv(c_u, c_g, w_dw, b_dw, g_n, b_n):
    u = c_u * jax.nn.sigmoid(c_g)
    u = lax.conv_general_dilated(u, w_dw[:, None, :].astype(u.dtype), window_strides=(1,),
                                 padding=[(CONV_TAPS // 2, CONV_TAPS // 2)],
                                 dimension_numbers=('NWC', 'WIO', 'NWC'),
                                 feature_group_count=CONV_WIDTH) + b_dw
    return jax.nn.silu(layer_norm(u, g_n, b_n))


def trunk_layer(x, mod, lw, latent, k_ctx=None, v_ctx=None, s_ctx=None):
    bsz, seq_len, _ = x.shape
    shift, scale, gate = jnp.split(mod, 3, axis=-1)
    h = layer_norm(x) * (1 + scale) + shift
    (a_q, a_k, a_v, a_z, b_q, b_k, b_v, b_lr, b_z,
     c_u, c_g, c_z, g_a, g_b, g_c) = split_cols(h @ lw['w_in'])
    heads = lambda t: t.reshape(bsz, seq_len, NA_HEADS, NA_HEAD_DIM)
    a_q, a_k, a_v = heads(a_q), heads(a_k), heads(a_v)
    if latent:
        o_a = neighbourhood_attention(a_q, a_k, a_v, k_ctx, v_ctx, lw['rpb'])
        s0 = s_ctx.astype(jnp.float32)
    else:
        o_a = context_attention(a_q, a_k, a_v)
        s0 = jnp.zeros((bsz, 2, GLA_HEADS, GLA_DK, GLA_DV), jnp.float32)
    o_b, s_fin = gla_branch(b_q, b_k, b_v, b_lr, lw['gla_w_gate'], lw['gla_b_gate'], lw['gla_norm_g'], s0, latent)
    o_c = conformer_conv(c_u, c_g, lw['conv_w'], lw['conv_b'], lw['conv_norm_g'], lw['conv_norm_b'])
    dt = x.dtype
    br_a = (o_a * jax.nn.silu(a_z)).astype(dt) @ lw['w_proj_a']
    br_b = (o_b * jax.nn.silu(b_z)).astype(dt) @ lw['w_proj_b']
    br_c = (o_c * jax.nn.silu(c_z)).astype(dt) @ lw['w_proj_c']
    merged = jax.nn.sigmoid(g_a) * br_a + jax.nn.sigmoid(g_b) * br_b + jax.nn.sigmoid(g_c) * br_c
    y = layer_norm(ALPHA * x + gate * (merged @ lw['w_out']), lw['ln_g'], lw['ln_b'])
    return y, a_k, a_v, s_fin.astype(dt)


def setup_inputs(seed: int = 0) -> dict:
    key = jax.random.key(seed)
    ks = jax.random.split(key, 26)
    nrm = lambda k, shape, s: jax.random.normal(k, shape, jnp.float32) * s
    return {
        'x_prompt': nrm(ks[0], (BATCH, SEQ, D_MODEL), 1.0),
        'x_sample': nrm(ks[1], (DEC_BATCH, DEC_SEQ, D_MODEL), 1.0),
        'cache_k': nrm(ks[2], (DEC_BATCH, DEPTH, PAST_LEN, NA_HEADS, NA_HEAD_DIM), 1.0),
        'cache_v': nrm(ks[3], (DEC_BATCH, DEPTH, PAST_LEN, NA_HEADS, NA_HEAD_DIM), 1.0),
        'state_gla': nrm(ks[4], (DEC_BATCH, DEPTH, 2, GLA_HEADS, GLA_DK, GLA_DV), 2.0),
        'c': nrm(ks[5], (DEC_BATCH, D_MODEL), 1.0),
        'c_ctx': nrm(ks[6], (D_MODEL,), 1.0),
        'w_mod': nrm(ks[7], (DEPTH, D_MODEL, 3 * D_MODEL), 0.5 * D_MODEL ** -0.5),
        'b_mod': nrm(ks[8], (DEPTH, 3 * D_MODEL), 0.01),
        'w_in': nrm(ks[9], (DEPTH, D_MODEL, N_IN), D_MODEL ** -0.5),
        'rpb': nrm(ks[10], (DEPTH, NA_HEADS, 2 * NA_WIN_H - 1, 2 * NA_WIN_W - 1), 0.1),
        'gla_w_gate': nrm(ks[11], (DEPTH, 2, GLA_LOWRANK, GLA_KW), GLA_LOWRANK ** -0.5),
        'gla_b_gate': nrm(ks[12], (DEPTH, 2, GLA_KW), 0.01),
        'gla_norm_g': 1.0 + nrm(ks[13], (DEPTH, GLA_VW), 0.01),
        'conv_w': nrm(ks[14], (DEPTH, CONV_TAPS, CONV_WIDTH), CONV_TAPS ** -0.5),
        'conv_b': nrm(ks[15], (DEPTH, CONV_WIDTH), 0.01),
        'conv_norm_g': 1.0 + nrm(ks[16], (DEPTH, CONV_WIDTH), 0.01),
        'conv_norm_b': nrm(ks[17], (DEPTH, CONV_WIDTH), 0.01),
        'w_proj_a': nrm(ks[18], (DEPTH, NA_WIDTH, D_MODEL), BETA * NA_WIDTH ** -0.5),
        'w_proj_b': nrm(ks[19], (DEPTH, GLA_VW, D_MODEL), BETA * GLA_VW ** -0.5),
        'w_proj_c': nrm(ks[20], (DEPTH, CONV_WIDTH, D_MODEL), BETA * CONV_WIDTH ** -0.5),
        'w_out': nrm(ks[21], (DEPTH, D_MODEL, D_MODEL), BETA * D_MODEL ** -0.5),
        'ln_g': 1.0 + nrm(ks[22], (DEPTH, D_MODEL), 0.01),
        'ln_b': nrm(ks[23], (DEPTH, D_MODEL), 0.01),
    }


def reference(x_prompt, x_sample, cache_k, cache_v, state_gla, c, c_ctx, w_mod, b_mod, w_in, rpb,
              gla_w_gate, gla_b_gate, gla_norm_g, conv_w, conv_b, conv_norm_g, conv_norm_b,
              w_proj_a, w_proj_b, w_proj_c, w_out, ln_g, ln_b):
    h_ctx = x_prompt
    h_lat = x_sample
    ks_list, vs_list, ss_list = [], [], []
    for l in range(DEPTH):
        lw = dict(w_in=w_in[l], rpb=rpb[l], gla_w_gate=gla_w_gate[l], gla_b_gate=gla_b_gate[l],
                  gla_norm_g=gla_norm_g[l], conv_w=conv_w[l], conv_b=conv_b[l],
                  conv_norm_g=conv_norm_g[l], conv_norm_b=conv_norm_b[l], w_proj_a=w_proj_a[l],
                  w_proj_b=w_proj_b[l], w_proj_c=w_proj_c[l], w_out=w_out[l], ln_g=ln_g[l], ln_b=ln_b[l])
        mod_ctx = (jax.nn.silu(c_ctx) @ w_mod[l] + b_mod[l])[None, None, :]
        h_ctx, k_l, v_l, s_l = trunk_layer(h_ctx, mod_ctx, lw, False)
        ks_list.append(k_l)
        vs_list.append(v_l)
        ss_list.append(s_l)
        mod_lat = (jax.nn.silu(c) @ w_mod[l] + b_mod[l])[:, None, :]
        h_lat = trunk_layer(h_lat, mod_lat, lw, True, cache_k[:, l], cache_v[:, l], state_gla[:, l])[0]
    new_k = jnp.stack(ks_list, axis=1)
    new_v = jnp.stack(vs_list, axis=1)
    new_state_gla = jnp.stack(ss_list, axis=1)
    return (h_ctx, h_lat, new_k, new_v, new_state_gla)
```

```cpp
#include <hip/hip_runtime.h>
#include <hip/hip_cooperative_groups.h>
#include <cstdio>
namespace cg = cooperative_groups;
namespace pg8 {
#define PG8_LAS __attribute__((address_space(3)))
typedef unsigned short bf16_t;
typedef short bf16x8 __attribute__((ext_vector_type(8)));
typedef float f32x4 __attribute__((ext_vector_type(4)));
typedef unsigned u32x4 __attribute__((ext_vector_type(4)));
constexpr int BM = 256, BK = 64, HALF = 128, HTB = HALF * BK * 2  , STAGE_BYTES = 8 * HTB, NXCD = 8, WGM = 8;

__host__ __device__ __forceinline__ int lds_byte(int r, int c) { const int st = (r >> 4) * 2 + (c >> 5), rr = r & 15, cc = c & 31, ob = rr * 64 + cc * 2; return st * 1024 + (ob ^ (((ob >> 9) & 1) << 5)); }
__host__ __device__ __forceinline__ void stage_rc(int b, int& R, int& C) { const int st = b / 1024, sb = b % 1024, swz = sb ^ (((sb >> 9) & 1) << 5); R = (st >> 1) * 16 + swz / 64; C = (st & 1) * 32 + (swz % 64) / 2; }
__host__ __device__ __forceinline__ int perm32(int rho) { const int n = rho >> 4, i = rho & 15; return 8 * (i >> 2) + 4 * n + (i & 3); }

struct Unit { int pm, pn; };
struct Gemm { const bf16_t* A; const bf16_t* Bt; int M, N, K; };

struct StaticOrder {
    int nM, nN, nwg, G, c;
    __host__ __device__ void init(int M, int N, int G_, int c_) { nM = M / BM; nN = N / BM; nwg = nM * nN; G = G_; c = c_; }
    __host__ __device__ bool next(int i, Unit& u) const {
        const long L = (long)i * G + c; if (L >= nwg) return false;
        int wgid = (int)L; { const int q = nwg / NXCD, r = nwg % NXCD, xcd = wgid % NXCD, off = wgid / NXCD; wgid = (xcd < r ? xcd * (q + 1) : r * (q + 1) + (xcd - r) * q) + off; }
        const int nig = WGM * nN, gid = wgid / nig, fm = gid * WGM, gsz = (nM - fm) < WGM ? (nM - fm) : WGM;
        u.pm = fm + ((wgid % nig) % gsz); u.pn = (wgid % nig) / gsz; return true;
    }
    __device__ __forceinline__ void a_ready(const Unit&) const {}
    __device__ __forceinline__ void done(const Unit&) const {}
};
typedef float f32x2_cv __attribute__((ext_vector_type(2))); typedef __bf16 bf16x2_cv __attribute__((ext_vector_type(2)));
__device__ __forceinline__ unsigned cvt_pk_bf16(float lo, float hi) { const f32x2_cv v = {lo, hi}; return __builtin_bit_cast(unsigned, __builtin_convertvector(v, bf16x2_cv)); }
template <class Epi, class Sched, bool STAMP = false>
__device__ __forceinline__ void gemm_phase(PG8_LAS unsigned char* lds, const Gemm g, const Sched& S, const Epi& E, unsigned long long* stamps) {
    int tid_ = threadIdx.x; asm volatile("" : "+v"(tid_)); const int tid = tid_, wid = __builtin_amdgcn_readfirstlane(tid >> 6), lane = tid & 63, wr = wid >> 2, wc = wid & 3, fr = lane & 15, fq = lane >> 4;
    const int K = g.K, nt = K / BK;
    int ts_lo = 0, ts_hi = 0, nts = 0; const unsigned long long rt_entry = STAMP ? (unsigned long long)wall_clock64() : 0ull;
#define PG8_STAMP() do { if (STAMP && wid == 0 && nts < 64) { const unsigned long long _c = (unsigned long long)clock64(); \
        ts_lo = (lane == nts) ? (int)(unsigned)_c : ts_lo; ts_hi = (lane == nts) ? (int)(unsigned)(_c >> 32) : ts_hi; ++nts; } } while (0)
    PG8_STAMP();
    unsigned voffA[2], voffB[2];
#pragma unroll
    for (int i = 0; i < 2; ++i) { int R, C; stage_rc(tid * 16 + i * 8192, R, C); const int Rb = Epi::PERM ? ((R & ~31) + perm32(R & 31)) : R;
        voffA[i] = (unsigned)(R * K + C) * 2u; voffB[i] = (unsigned)(Rb * K + C) * 2u; }
    const size_t kstep = (size_t)(BK * 2);
    const size_t hstep = (size_t)HALF * K * 2;
    const size_t tstep = 2 * hstep;
    const unsigned ldsw = (unsigned)wid * 1024u;
    const int aoff = lds_byte(wr * 64 + fr, fq * 8), boff = lds_byte(wc * 32 + fr, fq * 8);
#define PG8_SA(b, h) (((b) * 2 + (h)) * HTB)
#define PG8_SB(b, h) ((4 + (b) * 2 + (h)) * HTB)
#define PG8_STAGE(bufoff, gbase, voff) do { _Pragma("unroll") for (int _i = 0; _i < 2; ++_i) \
        __builtin_amdgcn_global_load_lds((const unsigned*)((const char*)(gbase) + (voff)[_i]), (PG8_LAS unsigned*)(lds + (bufoff) + ldsw + _i * 8192), 16, 0, 0); } while (0)
#define PG8_LDA(dst, b, h) do { _Pragma("unroll") for (int m = 0; m < 4; ++m) _Pragma("unroll") for (int k = 0; k < 2; ++k) dst[m][k] = *(const PG8_LAS bf16x8*)(lds + PG8_SA(b, h) + aoff + m * 2048 + k * 1024); } while (0)
#define PG8_LDB(dst, b, h) do { _Pragma("unroll") for (int n = 0; n < 2; ++n) _Pragma("unroll") for (int k = 0; k < 2; ++k) dst[n][k] = *(const PG8_LAS bf16x8*)(lds + PG8_SB(b, h) + boff + n * 2048 + k * 1024); } while (0)
#define PG8_MMA(ai, bj, At, Bt) do { __builtin_amdgcn_s_setprio(1); _Pragma("unroll") for (int m = 0; m < 4; ++m) _Pragma("unroll") for (int n = 0; n < 2; ++n) _Pragma("unroll") for (int k = 0; k < 2; ++k) \
        acc[ai][bj][m][n] = __builtin_amdgcn_mfma_f32_16x16x32_bf16(Bt[n][k], At[m][k], acc[ai][bj][m][n], 0, 0, 0); __builtin_amdgcn_s_setprio(0); } while (0)
#define PG8_WAIT_V(n) asm volatile("s_waitcnt vmcnt(" #n ")" ::: "memory")
#define PG8_WAIT_L(n) asm volatile("s_waitcnt lgkmcnt(" #n ")" ::: "memory")
#define PG8_BAR __builtin_amdgcn_s_barrier()
#define PG8_SCHED __builtin_amdgcn_sched_barrier(0)
    Unit cur, nxt; int ui = 0;
    if (!S.next(0, cur)) return;
    f32x4 acc[2][2][4][2];
#pragma unroll
    for (int a = 0; a < 2; ++a)
#pragma unroll
        for (int b = 0; b < 2; ++b)
#pragma unroll
            for (int m = 0; m < 4; ++m)
#pragma unroll
                for (int n = 0; n < 2; ++n) acc[a][b][m][n] = (f32x4){0.f, 0.f, 0.f, 0.f};
    bf16x8 At[4][2], B0[2][2], B1[2][2];
    const char* cA = (const char*)g.A + (size_t)cur.pm * tstep; const char* cB = (const char*)g.Bt + (size_t)cur.pn * tstep;
    S.a_ready(cur);
    PG8_STAGE(PG8_SB(0, 0), cB, voffB); PG8_STAGE(PG8_SA(0, 0), cA, voffA); PG8_STAGE(PG8_SB(0, 1), cB + hstep, voffB); PG8_STAGE(PG8_SA(0, 1), cA + hstep, voffA);
    if (wr == 1) PG8_BAR;
    PG8_WAIT_V(4); PG8_BAR;
    PG8_STAGE(PG8_SB(1, 0), cB + kstep, voffB); PG8_STAGE(PG8_SA(1, 0), cA + kstep, voffA); PG8_STAGE(PG8_SB(1, 1), cB + hstep + kstep, voffB);
    PG8_WAIT_V(6); PG8_BAR;
    PG8_STAMP();
    for (;;) {
        const bool has_next = S.next(ui + 1, nxt);
        const char* nA = has_next ? (const char*)g.A + (size_t)nxt.pm * tstep : cA; const char* nB = has_next ? (const char*)g.Bt + (size_t)nxt.pn * tstep : cB;
        for (int t = 0; t < nt; t += 2) {
            const bool last = (t == nt - 2);
            const char* a1 = cA + (size_t)(t + 1) * kstep;
            const char* a2 = last ? nA : cA + (size_t)(t + 2) * kstep; const char* b2 = last ? nB : cB + (size_t)(t + 2) * kstep;
            const char* a3 = a2 + kstep; const char* b3 = b2 + kstep;
            if (last && has_next) S.a_ready(nxt);
            PG8_LDB(B0, 0, 0); PG8_SCHED; PG8_LDA(At, 0, 0); PG8_STAGE(PG8_SA(1, 1), a1 + hstep, voffA);
            PG8_WAIT_L(8); PG8_BAR; PG8_WAIT_L(0); PG8_MMA(0, 0, At, B0); PG8_BAR; PG8_SCHED;
            PG8_LDB(B1, 0, 1); PG8_STAGE(PG8_SB(0, 0), b2, voffB);
            PG8_BAR; PG8_WAIT_L(0); PG8_MMA(0, 1, At, B1); PG8_BAR;
            PG8_LDA(At, 0, 1); PG8_STAGE(PG8_SA(0, 0), a2, voffA);
            PG8_BAR; PG8_WAIT_L(0); PG8_MMA(1, 0, At, B0); PG8_BAR; PG8_SCHED;
            PG8_STAGE(PG8_SB(0, 1), b2 + hstep, voffB);
            PG8_WAIT_V(6); PG8_BAR; PG8_MMA(1, 1, At, B1); PG8_BAR;
            PG8_LDB(B0, 1, 0); PG8_SCHED; PG8_LDA(At, 1, 0); PG8_STAGE(PG8_SA(0, 1), a2 + hstep, voffA);
            PG8_WAIT_L(8); PG8_BAR; PG8_WAIT_L(0); PG8_MMA(0, 0, At, B0); PG8_BAR; PG8_SCHED;
            PG8_LDB(B1, 1, 1); PG8_STAGE(PG8_SB(1, 0), b3, voffB);
            PG8_BAR; PG8_WAIT_L(0); PG8_MMA(0, 1, At, B1); PG8_BAR;
            PG8_LDA(At, 1, 1); PG8_STAGE(PG8_SA(1, 0), a3, voffA);
            PG8_BAR; PG8_WAIT_L(0); PG8_MMA(1, 0, At, B0); PG8_BAR; PG8_SCHED;
            PG8_STAGE(PG8_SB(1, 1), b3 + hstep, voffB);
            PG8_WAIT_V(6); PG8_BAR; PG8_MMA(1, 1, At, B1); PG8_BAR;
        }
        PG8_STAMP();
        if constexpr (!Epi::AFTER_DRAIN) { E(acc, cur, wr, wc, fr, fq); S.done(cur); }
        PG8_STAMP();
        if (!has_next) break;
#pragma unroll
        for (int a = 0; a < 2; ++a)
#pragma unroll
            for (int b = 0; b < 2; ++b)
#pragma unroll
                for (int m = 0; m < 4; ++m)
#pragma unroll
                    for (int n = 0; n < 2; ++n) acc[a][b][m][n] = (f32x4){0.f, 0.f, 0.f, 0.f};
        cur = nxt; cA = nA; cB = nB; ++ui;
    }
    PG8_WAIT_V(0);
    if (wr == 0) PG8_BAR;
    PG8_BAR;
    if constexpr (Epi::AFTER_DRAIN) { E.fused(acc, cur, wr, wc, fr, fq, lds, wid, lane); S.done(cur); }
    PG8_STAMP();
    if (STAMP && wid == 0) { stamps[lane] = lane < nts ? (((unsigned long long)(unsigned)ts_hi << 32) | (unsigned)ts_lo) : 0ull;
        if (lane == 62) stamps[62] = rt_entry; if (lane == 63) stamps[63] = (unsigned long long)wall_clock64(); }
#undef PG8_STAMP
#undef PG8_SA
#undef PG8_SB
#undef PG8_STAGE
#undef PG8_LDA
#undef PG8_LDB
#undef PG8_MMA
#undef PG8_WAIT_V
#undef PG8_WAIT_L
#undef PG8_BAR
#undef PG8_SCHED
}
}

namespace mk {
using pg8::bf16_t; using pg8::bf16x8; using pg8::f32x4; using pg8::u32x4; using pg8::Unit; using pg8::Gemm; using pg8::StaticOrder; using pg8::cvt_pk_bf16;
#define LAS __attribute__((address_space(3)))
typedef short bf16x4 __attribute__((ext_vector_type(4)));
typedef unsigned u32x2 __attribute__((ext_vector_type(2)));

constexpr int T_ALL = 12288, T_CTX = 8192, DM = 2048, NP = 15360, NIN = 16416;
constexpr int PQ = 0, PK = 1024, PZA = 2048, PBQ = 3072, PBK = 3584, PBV = 4096, PBZ = 5120, PCU = 6144, PCG = 7168, PCZ = 8192, PGA = 9216, PGB = 11264, PGC = 13312;
constexpr float ATT_SCALE = 0.08838834764831845f;
constexpr float ALPHA_DN = 1.4142135623730951f;
constexpr size_t OUT_Y = 0, OUT_K = 25165824ull, OUT_V = 41943040ull, OUT_S = 58720256ull;

constexpr size_t WS_CTL = 0;
constexpr size_t WS_MOD = 4096;
constexpr size_t WS_BTIN = 4096 + 147456;
constexpr size_t WS_BTBR = WS_BTIN + 2ull * 16416 * 2048 * 2;
constexpr size_t WS_BTOUT = WS_BTBR + 2ull * 6144 * 1024 * 2;
constexpr size_t WS_CK = WS_BTOUT + 2ull * 2048 * 2048 * 2;
constexpr size_t WS_CVT = WS_CK + 4ull * 256 * 1024 * 2;
constexpr size_t WS_H = WS_CVT + 4ull * 256 * 1024 * 2;
constexpr size_t WS_VT = WS_H + 12288ull * 2048 * 2;
constexpr size_t WS_LR = WS_VT + 1024ull * 12288 * 2;
constexpr size_t WS_YCAT = WS_LR + 12288ull * 32 * 4;
constexpr size_t WS_MRG = WS_YCAT + 3ull * 12288 * 1024 * 2;
constexpr size_t WS_X1 = WS_MRG + 12288ull * 2048 * 2;
constexpr size_t WS_OG = WS_X1 + 12288ull * 2048 * 4;
constexpr size_t WS_P = WS_OG + 2ull * 12288 * 1024 * 4;
constexpr size_t WS_END = WS_P + 12288ull * 15360 * 2;
constexpr int LDS_BYTES = 131072 + 1024;
constexpr int LDS_CTL = 131072;

struct Params {
    const float *x_prompt, *x_sample, *cache_k, *cache_v, *state_gla, *c, *c_ctx, *w_mod, *b_mod, *w_in, *rpb, *gla_w_gate, *gla_b_gate, *gla_norm_g,
        *conv_w, *conv_b, *conv_norm_g, *conv_norm_b, *w_proj_a, *w_proj_b, *w_proj_c, *w_out, *ln_g, *ln_b;
    float* out; unsigned char* ws;
};

__device__ __forceinline__ int otid() { int t = threadIdx.x; asm volatile("" : "+v"(t)); return t; }
__device__ __forceinline__ float bf2f(bf16_t b) { return __uint_as_float(((unsigned)b) << 16); }
__device__ __forceinline__ float bflo(unsigned w) { return __uint_as_float(w << 16); }
__device__ __forceinline__ float bfhi(unsigned w) { return __uint_as_float(w & 0xffff0000u); }
__device__ __forceinline__ bf16_t f2bf(float f) { unsigned u = __float_as_uint(f); u += 0x7FFFu + ((u >> 16) & 1u); return (bf16_t)(u >> 16); }
__device__ __forceinline__ float sigmoidf_(float x) { return 1.0f / (1.0f + __expf(-x)); }
__device__ __forceinline__ float siluf_(float x) { return x / (1.0f + __expf(-x)); }
__device__ __forceinline__ float wsum(float v) { for (int o = 32; o >= 1; o >>= 1) v += __shfl_xor(v, o); return v; }
__device__ __forceinline__ f32x4 mfma16(bf16x8 a, bf16x8 b, f32x4 c) { return __builtin_amdgcn_mfma_f32_16x16x32_bf16(a, b, c, 0, 0, 0); }

__device__ __forceinline__ void tr_tile(const float* src, size_t ld, bf16_t* dst, size_t dstK, LAS float* t) {
    const int tid = otid();
#pragma unroll
    for (int it = 0; it < 2; ++it) { const int k = it * 64 + (tid >> 3), n4 = (tid & 7) * 4; const float4 v = *(const float4*)(src + (size_t)k * ld + n4);
        t[k * 33 + n4] = v.x; t[k * 33 + n4 + 1] = v.y; t[k * 33 + n4 + 2] = v.z; t[k * 33 + n4 + 3] = v.w; }
    __syncthreads();
    { const int n = tid >> 4, k8 = (tid & 15) * 8; u32x4 w;
        w.x = cvt_pk_bf16(t[(k8 + 0) * 33 + n], t[(k8 + 1) * 33 + n]); w.y = cvt_pk_bf16(t[(k8 + 2) * 33 + n], t[(k8 + 3) * 33 + n]);
        w.z = cvt_pk_bf16(t[(k8 + 4) * 33 + n], t[(k8 + 5) * 33 + n]); w.w = cvt_pk_bf16(t[(k8 + 6) * 33 + n], t[(k8 + 7) * 33 + n]);
        *(u32x4*)(dst + (size_t)n * dstK + k8) = w; }
    __syncthreads();
}
__device__ __forceinline__ int win_row(int n) {
    if (n < 2048) return n;
    if (n < 3072) return 15360 + (n - 2048);
    if (n < 4096) return 2048 + (n - 3072);
    if (n < 6144) return 3072 + (n - 4096);
    if (n < 6176) return 16384 + (n - 6144);
    return 5120 + (n - 6176);
}
__device__ __forceinline__ void phase0(const Params p, LAS unsigned char* lds) {
    const int tid = otid(); unsigned char* ws = p.ws;
    if (blockIdx.x == 0 && tid < 64) ((unsigned*)(ws + WS_CTL))[tid] = 0u;
    LAS float* t = (LAS float*)lds;
    bf16_t* btin = (bf16_t*)(ws + WS_BTIN); bf16_t* btbr = (bf16_t*)(ws + WS_BTBR); bf16_t* btout = (bf16_t*)(ws + WS_BTOUT); bf16_t* cvt = (bf16_t*)(ws + WS_CVT);
    float* modp = (float*)(ws + WS_P);
    constexpr int J_MOD = 256, J_WIN = 2 * 513 * 16, J_WBR = 2 * 3 * 512, J_WOUT = 2 * 1024, J_CV = 4 * 64;
    for (int j = blockIdx.x; j < J_MOD + J_WIN + J_WBR + J_WOUT + J_CV; j += gridDim.x) {
        int q = j;
        if (q < J_MOD) {
            const int l = q >> 7, slab = q & 127, k0 = slab * 16;
            float acc[3][12];
#pragma unroll
            for (int v = 0; v < 3; ++v)
#pragma unroll
                for (int i = 0; i < 12; ++i) acc[v][i] = 0.f;
            for (int kk = 0; kk < 16; ++kk) { const int k = k0 + kk;
                const float s0 = siluf_(p.c_ctx[k]), s1 = siluf_(p.c[k]), s2 = siluf_(p.c[2048 + k]);
                const float* wr_ = p.w_mod + ((size_t)l * 2048 + k) * 6144 + tid * 4;
#pragma unroll
                for (int jx = 0; jx < 3; ++jx) { const float4 w = *(const float4*)(wr_ + jx * 2048);
                    acc[0][jx * 4 + 0] += s0 * w.x; acc[0][jx * 4 + 1] += s0 * w.y; acc[0][jx * 4 + 2] += s0 * w.z; acc[0][jx * 4 + 3] += s0 * w.w;
                    acc[1][jx * 4 + 0] += s1 * w.x; acc[1][jx * 4 + 1] += s1 * w.y; acc[1][jx * 4 + 2] += s1 * w.z; acc[1][jx * 4 + 3] += s1 * w.w;
                    acc[2][jx * 4 + 0] += s2 * w.x; acc[2][jx * 4 + 1] += s2 * w.y; acc[2][jx * 4 + 2] += s2 * w.z; acc[2][jx * 4 + 3] += s2 * w.w; } }
#pragma unroll
            for (int v = 0; v < 3; ++v)
#pragma unroll
                for (int jx = 0; jx < 3; ++jx) { float4 o; o.x = acc[v][jx * 4]; o.y = acc[v][jx * 4 + 1]; o.z = acc[v][jx * 4 + 2]; o.w = acc[v][jx * 4 + 3];
                    *(float4*)(modp + ((size_t)(l * 128 + slab) * 3 + v) * 6144 + jx * 2048 + tid * 4) = o; }
            continue;
        }
        q -= J_MOD;
        if (q < J_WIN) { const int l = q / 8208, rem = q % 8208, nt = rem >> 4, kt = rem & 15, n0 = nt * 32, k0 = kt * 128;
            tr_tile(p.w_in + ((size_t)l * 2048 + k0) * NIN + n0, NIN, btin + ((size_t)l * 16416 + win_row(n0)) * 2048 + k0, 2048, t); continue; }
        q -= J_WIN;
        if (q < J_WBR) { const int l = q / 1536, rem = q % 1536, br = rem >> 9, r2 = rem & 511, nt = r2 >> 3, kt = r2 & 7, n0 = nt * 32, k0 = kt * 128;
            const float* w = (br == 0 ? p.w_proj_a : (br == 1 ? p.w_proj_b : p.w_proj_c)) + (size_t)l * 1024 * 2048;
            tr_tile(w + (size_t)k0 * 2048 + n0, 2048, btbr + ((size_t)l * 6144 + br * 2048 + n0) * 1024 + k0, 1024, t); continue; }
        q -= J_WBR;
        if (q < J_WOUT) { const int l = q >> 10, rem = q & 1023, nt = rem >> 4, kt = rem & 15, n0 = nt * 32, k0 = kt * 128;
            tr_tile(p.w_out + ((size_t)l * 2048 + k0) * 2048 + n0, 2048, btout + ((size_t)l * 2048 + n0) * 2048 + k0, 2048, t); continue; }
        q -= J_WOUT;
        { const int bl = q >> 6, rem = q & 63, nt = rem >> 1, kt = rem & 1, n0 = nt * 32, k0 = kt * 128;
            tr_tile(p.cache_v + ((size_t)bl * 256 + k0) * 1024 + n0, 1024, cvt + ((size_t)bl * 1024 + n0) * 256 + k0, 256, t); }
    }
    bf16_t* ck = (bf16_t*)(ws + WS_CK);
    for (size_t i = (size_t)blockIdx.x * 512 + tid; i < 131072; i += (size_t)gridDim.x * 512) {
        const float4 a = *(const float4*)(p.cache_k + i * 8), b = *(const float4*)(p.cache_k + i * 8 + 4);
        u32x4 w; w.x = cvt_pk_bf16(a.x, a.y); w.y = cvt_pk_bf16(a.z, a.w); w.z = cvt_pk_bf16(b.x, b.y); w.w = cvt_pk_bf16(b.z, b.w);
        *(u32x4*)(ck + i * 8) = w; }
}
__device__ __forceinline__ void phase0b(const Params p) {
    const float* modp = (const float*)(p.ws + WS_P); float* mod = (float*)(p.ws + WS_MOD);
    for (int idx = blockIdx.x * 512 + otid(); idx < 36864; idx += gridDim.x * 512) {
        const int l = idx / 18432, rem = idx % 18432, v = rem / 6144, n = rem % 6144;
        float s = p.b_mod[l * 6144 + n];
#pragma unroll 8
        for (int sl = 0; sl < 128; ++sl) s += modp[((size_t)(l * 128 + sl) * 3 + v) * 6144 + n];
        mod[idx] = s; }
}

template <int MODE> __device__ __forceinline__ void ln_phase(const Params p, int l) {
    const int tid = otid(), wid = tid >> 6, lane = tid & 63;
    const float* Z = (const float*)(p.ws + WS_P); float* X1 = (float*)(p.ws + WS_X1); bf16_t* H = (bf16_t*)(p.ws + WS_H); const float* mod = (const float*)(p.ws + WS_MOD);
    for (int row = blockIdx.x * 8 + wid; row < T_ALL; row += gridDim.x * 8) {
        const float* src = (MODE == 0) ? (row < T_CTX ? p.x_prompt + (size_t)row * DM : p.x_sample + (size_t)(row - T_CTX) * DM) : Z + (size_t)row * DM;
        float4 v[8]; float s = 0.f;
#pragma unroll
        for (int j = 0; j < 8; ++j) { v[j] = *(const float4*)(src + j * 256 + lane * 4); s += (v[j].x + v[j].y) + (v[j].z + v[j].w); }
        float mean = wsum(s) * (1.0f / 2048.0f), q = 0.f;
#pragma unroll
        for (int j = 0; j < 8; ++j) { const float a = v[j].x - mean, b = v[j].y - mean, c = v[j].z - mean, d = v[j].w - mean; q += (a * a + b * b) + (c * c + d * d); }
        float rstd = rsqrtf(wsum(q) * (1.0f / 2048.0f) + 1e-5f);
        if (MODE >= 1) {
            const float* g = p.ln_g + (size_t)(l - 1) * DM; const float* bb = p.ln_b + (size_t)(l - 1) * DM;
            float* dst = (MODE == 2) ? p.out + OUT_Y + (size_t)row * DM : X1 + (size_t)row * DM; s = 0.f;
#pragma unroll
            for (int j = 0; j < 8; ++j) { const float4 gg = *(const float4*)(g + j * 256 + lane * 4), b4 = *(const float4*)(bb + j * 256 + lane * 4);
                v[j].x = (v[j].x - mean) * rstd * gg.x + b4.x; v[j].y = (v[j].y - mean) * rstd * gg.y + b4.y; v[j].z = (v[j].z - mean) * rstd * gg.z + b4.z; v[j].w = (v[j].w - mean) * rstd * gg.w + b4.w;
                *(float4*)(dst + j * 256 + lane * 4) = v[j]; s += (v[j].x + v[j].y) + (v[j].z + v[j].w); }
            if (MODE == 2) continue;
            mean = wsum(s) * (1.0f / 2048.0f); q = 0.f;
#pragma unroll
            for (int j = 0; j < 8; ++j) { const float a = v[j].x - mean, b = v[j].y - mean, c = v[j].z - mean, d = v[j].w - mean; q += (a * a + b * b) + (c * c + d * d); }
            rstd = rsqrtf(wsum(q) * (1.0f / 2048.0f) + 1e-5f);
        }
        const int vv = row < T_CTX ? 0 : 1 + ((row - T_CTX) >> 11);
        const float* md = mod + (size_t)(l * 3 + vv) * 6144;
#pragma unroll
        for (int j = 0; j < 8; ++j) { const float4 sh = *(const float4*)(md + j * 256 + lane * 4), sc = *(const float4*)(md + 2048 + j * 256 + lane * 4);
            u32x2 w; w.x = cvt_pk_bf16((v[j].x - mean) * rstd * (1.0f + sc.x) + sh.x, (v[j].y - mean) * rstd * (1.0f + sc.y) + sh.y);
            w.y = cvt_pk_bf16((v[j].z - mean) * rstd * (1.0f + sc.z) + sh.z, (v[j].w - mean) * rstd * (1.0f + sc.w) + sh.w);
            *(u32x2*)(H + (size_t)row * DM + j * 256 + lane * 4) = w; }
    }
}

__device__ __forceinline__ void lr_phase(const Params p, int l) {
    const int tid = otid(), wid = tid >> 6, lane = tid & 63, r = lane & 15, qd = lane >> 4;
    const bf16_t* H = (const bf16_t*)(p.ws + WS_H); const bf16_t* bt = (const bf16_t*)(p.ws + WS_BTIN) + ((size_t)l * 16416 + 16384) * 2048; float* LR = (float*)(p.ws + WS_LR);
    for (int it = blockIdx.x * 8 + wid; it < T_ALL / 16; it += gridDim.x * 8) {
        const bf16_t* ap = H + (size_t)(it * 16 + r) * DM + qd * 8; const bf16_t* b0 = bt + (size_t)r * 2048 + qd * 8; const bf16_t* b1 = b0 + 16 * 2048;
        f32x4 c0 = {0.f, 0.f, 0.f, 0.f}, c1 = {0.f, 0.f, 0.f, 0.f};
#pragma unroll 8
        for (int ks = 0; ks < 64; ++ks) { const bf16x8 a = *(const bf16x8*)(ap + ks * 32); c0 = mfma16(a, *(const bf16x8*)(b0 + ks * 32), c0); c1 = mfma16(a, *(const bf16x8*)(b1 + ks * 32), c1); }
#pragma unroll
        for (int jj = 0; jj < 4; ++jj) { float* o = LR + (size_t)(it * 16 + qd * 4 + jj) * 32; o[r] = c0[jj]; o[16 + r] = c1[jj]; }
    }
}

struct EpiIn {
    static constexpr bool PERM = true, AFTER_DRAIN = false;
    bf16_t* P; float* newk; int l;
    __device__ __forceinline__ void operator()(const f32x4 (&acc)[2][2][4][2], const Unit& u, int wr, int wc, int fr, int fq) const {
        const int row0 = u.pm * 256 + wr * 64 + fr, col0 = u.pn * 256 + wc * 32 + 8 * fq; const bool isk = (u.pn >= 4) && (u.pn < 8) && (u.pm < 32);
#pragma unroll
        for (int ai = 0; ai < 2; ++ai)
#pragma unroll
            for (int m = 0; m < 4; ++m) { const int r = row0 + ai * 128 + m * 16;
#pragma unroll
                for (int bj = 0; bj < 2; ++bj) { const int c = col0 + bj * 128; const f32x4 v0 = acc[ai][bj][m][0], v1 = acc[ai][bj][m][1];
                    u32x4 w; w.x = cvt_pk_bf16(v0[0], v0[1]); w.y = cvt_pk_bf16(v0[2], v0[3]); w.z = cvt_pk_bf16(v1[0], v1[1]); w.w = cvt_pk_bf16(v1[2], v1[3]);
                    *(u32x4*)(P + (size_t)r * NP + c) = w;
                    if (isk) { float* d = newk + ((size_t)((r >> 8) * 2 + l) * 256 + (r & 255)) * 1024 + (c - 1024); *(f32x4*)d = v0; *(f32x4*)(d + 4) = v1; } } }
    }
};
struct EpiV {
    static constexpr bool PERM = true, AFTER_DRAIN = false;
    bf16_t* VT; float* newv; int l;
    __device__ __forceinline__ void operator()(const f32x4 (&acc)[2][2][4][2], const Unit& u, int wr, int wc, int fr, int fq) const {
        const int row0 = u.pm * 256 + wr * 64 + fr, col0 = u.pn * 256 + wc * 32 + 8 * fq; const bool isv = u.pn < 32;
#pragma unroll
        for (int ai = 0; ai < 2; ++ai)
#pragma unroll
            for (int m = 0; m < 4; ++m) { const int r = row0 + ai * 128 + m * 16;
#pragma unroll
                for (int bj = 0; bj < 2; ++bj) { const int c = col0 + bj * 128; const f32x4 v0 = acc[ai][bj][m][0], v1 = acc[ai][bj][m][1];
                    u32x4 w; w.x = cvt_pk_bf16(v0[0], v0[1]); w.y = cvt_pk_bf16(v0[2], v0[3]); w.z = cvt_pk_bf16(v1[0], v1[1]); w.w = cvt_pk_bf16(v1[2], v1[3]);
                    *(u32x4*)(VT + (size_t)r * T_ALL + c) = w;
                    if (isv) { float* d = newv + ((size_t)((c >> 8) * 2 + l) * 256 + (c & 255)) * 1024 + r;
#pragma unroll
                        for (int j = 0; j < 4; ++j) { d[(size_t)j * 1024] = v0[j]; d[(size_t)(j + 4) * 1024] = v1[j]; } } } }
    }
};
struct BrOrder {
    StaticOrder so;
    __device__ bool next(int i, Unit& u) const { const int tile = i / 3, br = i - tile * 3; Unit t; if (!so.next(tile, t)) return false; u.pm = br * 48 + t.pm; u.pn = br * 8 + t.pn; return true; }
    __device__ __forceinline__ void a_ready(const Unit&) const {}
    __device__ __forceinline__ void done(const Unit&) const {}
};
struct EpiBr {
    static constexpr bool PERM = true, AFTER_DRAIN = false;
    const bf16_t* P; float* M32; bf16_t* MRG;
    __device__ __forceinline__ void operator()(const f32x4 (&acc)[2][2][4][2], const Unit& u, int wr, int wc, int fr, int fq) const {
        const int br = u.pm / 48, pm = u.pm - br * 48, pn = u.pn - br * 8;
        const int row0 = pm * 256 + wr * 64 + fr, col0 = pn * 256 + wc * 32 + 8 * fq; const int gbase = (br == 0 ? PGA : (br == 1 ? PGB : PGC));
#pragma unroll
        for (int ai = 0; ai < 2; ++ai)
#pragma unroll
            for (int m = 0; m < 4; ++m) { const int r = row0 + ai * 128 + m * 16;
#pragma unroll
                for (int bj = 0; bj < 2; ++bj) { const int c = col0 + bj * 128; const u32x4 g = *(const u32x4*)(P + (size_t)r * NP + gbase + c);
                    f32x4 v0 = acc[ai][bj][m][0], v1 = acc[ai][bj][m][1];
                    v0[0] *= sigmoidf_(bflo(g.x)); v0[1] *= sigmoidf_(bfhi(g.x)); v0[2] *= sigmoidf_(bflo(g.y)); v0[3] *= sigmoidf_(bfhi(g.y));
                    v1[0] *= sigmoidf_(bflo(g.z)); v1[1] *= sigmoidf_(bfhi(g.z)); v1[2] *= sigmoidf_(bflo(g.w)); v1[3] *= sigmoidf_(bfhi(g.w));
#ifdef DROP_BR
                    if (br == DROP_BR) { v0 = (f32x4){0.f, 0.f, 0.f, 0.f}; v1 = v0; }
#endif
                    float* d = M32 + (size_t)r * DM + c;
                    if (br > 0) { v0 += *(const f32x4*)d; v1 += *(const f32x4*)(d + 4); }
                    if (br < 2) { *(f32x4*)d = v0; *(f32x4*)(d + 4) = v1; }
                    else { u32x4 w; w.x = cvt_pk_bf16(v0[0], v0[1]); w.y = cvt_pk_bf16(v0[2], v0[3]); w.z = cvt_pk_bf16(v1[0], v1[1]); w.w = cvt_pk_bf16(v1[2], v1[3]); *(u32x4*)(MRG + (size_t)r * DM + c) = w; } } }
    }
};
struct EpiOut {
    static constexpr bool PERM = false, AFTER_DRAIN = false;
    const float *xp, *xs, *x1; const float* mod; float* Z; int l;
    __device__ __forceinline__ void operator()(const f32x4 (&acc)[2][2][4][2], const Unit& u, int wr, int wc, int fr, int fq) const {
        const int row0 = u.pm * 256 + wr * 64 + fr, col0 = u.pn * 256 + wc * 32 + 4 * fq;
#pragma unroll
        for (int ai = 0; ai < 2; ++ai)
#pragma unroll
            for (int m = 0; m < 4; ++m) { const int r = row0 + ai * 128 + m * 16;
                const float* x = (l == 0) ? (r < T_CTX ? xp + (size_t)r * DM : xs + (size_t)(r - T_CTX) * DM) : x1 + (size_t)r * DM;
                const int vv = r < T_CTX ? 0 : 1 + ((r - T_CTX) >> 11); const float* gt = mod + (size_t)(l * 3 + vv) * 6144 + 4096;
#pragma unroll
                for (int bj = 0; bj < 2; ++bj)
#pragma unroll
                    for (int n = 0; n < 2; ++n) { const int c = col0 + bj * 128 + n * 16; const f32x4 xv = *(const f32x4*)(x + c), gv = *(const f32x4*)(gt + c);
                        *(f32x4*)(Z + (size_t)r * DM + c) = ALPHA_DN * xv + gv * acc[ai][bj][m][n]; } }
    }
};

template <bool WIN> __device__ __forceinline__ void att_half(const bf16x8 (&qf)[4], const bf16_t* Kb, size_t kstride, const bf16_t* Vtb, size_t vstride, int tb0, int tbs,
                                                            f32x4 (&o)[8], float& m, float& lsum, int r, int qd, const float* rpb_h, int drbase, int qc, int bs) {
    f32x4 sc[16];
#pragma unroll
    for (int kt = 0; kt < 16; ++kt) { const int tok = tb0 + (kt >> 1) * tbs + (kt & 1) * 16 + r; const bf16_t* kp = Kb + (size_t)tok * kstride + qd * 8;
        f32x4 a = {0.f, 0.f, 0.f, 0.f};
#pragma unroll
        for (int ks = 0; ks < 4; ++ks) a = mfma16(*(const bf16x8*)(kp + ks * 32), qf[ks], a);
        sc[kt] = a; }
    float mx = m;
    const int cs = min(max(qc - 8, 0), 48);
#pragma unroll
    for (int kt = 0; kt < 16; ++kt)
#pragma unroll
        for (int jj = 0; jj < 4; ++jj) { float v = sc[kt][jj] * ATT_SCALE;
            if (WIN) { const int kc = bs + (kt & 1) * 16 + qd * 4 + jj; const bool valid = (kc >= cs) && (kc < cs + 16); const int dci = min(max(kc - qc + 15, 0), 30);
                const float bias = rpb_h[(drbase + (kt >> 1)) * 31 + dci]; v = valid ? v + bias : -1e30f; }
            sc[kt][jj] = v; mx = fmaxf(mx, v); }
    mx = fmaxf(mx, __shfl_xor(mx, 16)); mx = fmaxf(mx, __shfl_xor(mx, 32));
    const float alpha = __expf(m - mx); m = mx; lsum *= alpha;
#pragma unroll
    for (int dt = 0; dt < 8; ++dt) o[dt] *= alpha;
    unsigned pk[16][2];
#pragma unroll
    for (int kt = 0; kt < 16; ++kt) { const float p0 = __expf(sc[kt][0] - mx), p1 = __expf(sc[kt][1] - mx), p2 = __expf(sc[kt][2] - mx), p3 = __expf(sc[kt][3] - mx);
        lsum += (p0 + p1) + (p2 + p3); pk[kt][0] = cvt_pk_bf16(p0, p1); pk[kt][1] = cvt_pk_bf16(p2, p3); }
#pragma unroll
    for (int g = 0; g < 8; ++g) { u32x4 bw; bw.x = pk[2 * g][0]; bw.y = pk[2 * g][1]; bw.z = pk[2 * g + 1][0]; bw.w = pk[2 * g + 1][1];
        const bf16x8 b = __builtin_bit_cast(bf16x8, bw);
#pragma unroll
        for (int dt = 0; dt < 8; ++dt) { const bf16_t* vp = Vtb + (size_t)(dt * 16 + r) * vstride + tb0 + g * tbs + qd * 4;
            const bf16x4 lo = *(const bf16x4*)vp, hi = *(const bf16x4*)(vp + 16);
            o[dt] = mfma16(__builtin_shufflevector(lo, hi, 0, 1, 2, 3, 4, 5, 6, 7), b, o[dt]); } }
}
__device__ __forceinline__ void att_wave(const Params p, int l, bool latent, int b, int h, int tokq0, int row, int t16) {
    const int lane = otid() & 63, r = lane & 15, qd = lane >> 4;
    const bf16_t* P = (const bf16_t*)(p.ws + WS_P); const bf16_t* VT = (const bf16_t*)(p.ws + WS_VT); bf16_t* YA = (bf16_t*)(p.ws + WS_YCAT);
    bf16x8 qf[4];
    { const bf16_t* qp = P + (size_t)(tokq0 + r) * NP + PQ + h * 128 + qd * 8;
#pragma unroll
        for (int ks = 0; ks < 4; ++ks) qf[ks] = *(const bf16x8*)(qp + ks * 32); }
    f32x4 o[8];
#pragma unroll
    for (int dt = 0; dt < 8; ++dt) o[dt] = (f32x4){0.f, 0.f, 0.f, 0.f};
    float m = -1e30f, lsum = 0.f;
    if (!latent) {
        att_half<false>(qf, P + (size_t)(b * 256) * NP + PK + h * 128, NP, VT + (size_t)(h * 128) * T_ALL + b * 256, T_ALL, 0, 32, o, m, lsum, r, qd, nullptr, 0, 0, 0);
    } else {
        const int rs = min(max(row - 4, 0), 24), bs = min(max(16 * t16 - 8, 0), 32), tokb = T_CTX + b * 2048;
        att_half<true>(qf, P + (size_t)tokb * NP + PK + h * 128, NP, VT + (size_t)(h * 128) * T_ALL + tokb, T_ALL, rs * 64 + bs, 64, o, m, lsum, r, qd,
                       p.rpb + (size_t)(l * 8 + h) * 15 * 31, rs - row + 7, t16 * 16 + r, bs);
        att_half<false>(qf, (const bf16_t*)(p.ws + WS_CK) + (size_t)((b * 2 + l) * 256) * 1024 + h * 128, 1024,
                        (const bf16_t*)(p.ws + WS_CVT) + (size_t)((b * 2 + l) * 1024 + h * 128) * 256, 256, 0, 32, o, m, lsum, r, qd, nullptr, 0, 0, 0);
    }
    lsum += __shfl_xor(lsum, 16); lsum += __shfl_xor(lsum, 32);
#if defined(PROBE_ZERO_LAT)
    const float inv = latent ? 0.f : 1.0f / lsum;
#elif defined(PROBE_ZERO_CTX)
    const float inv = latent ? 1.0f / lsum : 0.f;
#else
    const float inv = 1.0f / lsum;
#endif
    const size_t tok = (size_t)(tokq0 + r);
#pragma unroll
    for (int dt = 0; dt < 8; ++dt) { const int dim = h * 128 + dt * 16 + qd * 4; const u32x2 z = *(const u32x2*)(P + tok * NP + PZA + dim);
        u32x2 w; w.x = cvt_pk_bf16(o[dt][0] * inv * siluf_(bflo(z.x)), o[dt][1] * inv * siluf_(bfhi(z.x))); w.y = cvt_pk_bf16(o[dt][2] * inv * siluf_(bflo(z.y)), o[dt][3] * inv * siluf_(bfhi(z.y)));
        *(u32x2*)(YA + tok * 1024 + dim) = w; }
}

constexpr int G_QE = 0, G_KE = 17408, G_KLT = 34816, G_VT = 53248, G_ATT = 62464, G_ST = 71680, G_WG = 89088, G_BG = 97280, G_BL = 97792;
__device__ __forceinline__ void gla_item(const Params p, int l, bool latent, int b, int h, int dir, int sl, LAS unsigned char* lds) {
    const int tid = otid(), w = tid >> 6, lane = tid & 63, r = lane & 15, qd = lane >> 4;
    const int L = latent ? 2048 : 256, nch = L >> 6, tok0 = latent ? T_CTX + b * 2048 : b * 256;
    const bf16_t* P = (const bf16_t*)(p.ws + WS_P); const float* LR = (const float*)(p.ws + WS_LR); float* OG = (float*)(p.ws + WS_OG) + (size_t)dir * T_ALL * 1024;
    LAS bf16_t* QE = (LAS bf16_t*)(lds + G_QE); LAS bf16_t* KE = (LAS bf16_t*)(lds + G_KE); LAS bf16_t* KLT = (LAS bf16_t*)(lds + G_KLT); LAS bf16_t* VTs = (LAS bf16_t*)(lds + G_VT);
    LAS bf16_t* ATT = (LAS bf16_t*)(lds + G_ATT); LAS bf16_t* ST = (LAS bf16_t*)(lds + G_ST); LAS float* WG = (LAS float*)(lds + G_WG); LAS float* BG = (LAS float*)(lds + G_BG); LAS float* BL = (LAS float*)(lds + G_BL);
    for (int i = tid; i < 2048; i += 512) WG[i] = p.gla_w_gate[((size_t)(l * 2 + dir) * 16 + (i >> 7)) * 512 + h * 128 + (i & 127)];
    if (tid < 128) BG[tid] = p.gla_b_gate[(size_t)(l * 2 + dir) * 512 + h * 128 + tid];
    f32x4 S[4];
    const size_t sidx = ((((size_t)(b * 2 + l) * 2 + dir) * 4 + h) * 128 + w * 16 + qd * 4) * 256 + sl * 64 + r;
#pragma unroll
    for (int et = 0; et < 4; ++et)
#pragma unroll
        for (int jj = 0; jj < 4; ++jj) S[et][jj] = latent ? p.state_gla[sidx + (size_t)jj * 256 + et * 16] : 0.f;
#pragma unroll
    for (int et = 0; et < 4; ++et) { u32x2 wv; wv.x = cvt_pk_bf16(S[et][0], S[et][1]); wv.y = cvt_pk_bf16(S[et][2], S[et][3]); *(LAS u32x2*)(ST + (et * 16 + r) * 136 + w * 16 + qd * 4) = wv; }
    __syncthreads();
    const int d0 = w * 16;
    for (int c = 0; c < nch; ++c) {
        { const int pos = c * 64 + lane; const int tl = dir ? (L - 1 - pos) : pos; const size_t tok = (size_t)(tok0 + tl); const bf16_t* prow = P + tok * NP;
            float qv[16], kv[16];
            { const u32x4 a0 = *(const u32x4*)(prow + PBQ + h * 128 + d0), a1 = *(const u32x4*)(prow + PBQ + h * 128 + d0 + 8);
              const u32x4 b0 = *(const u32x4*)(prow + PBK + h * 128 + d0), b1 = *(const u32x4*)(prow + PBK + h * 128 + d0 + 8);
              const unsigned aw[8] = {a0.x, a0.y, a0.z, a0.w, a1.x, a1.y, a1.z, a1.w}, bw[8] = {b0.x, b0.y, b0.z, b0.w, b1.x, b1.y, b1.z, b1.w};
#pragma unroll
              for (int i = 0; i < 8; ++i) { qv[2 * i] = bflo(aw[i]); qv[2 * i + 1] = bfhi(aw[i]); kv[2 * i] = bflo(bw[i]); kv[2 * i + 1] = bfhi(bw[i]); } }
            if (latent) {
                const int dp = d0 ^ 32; float qp[16], kp2[16];
                { const u32x4 a0 = *(const u32x4*)(prow + PBQ + h * 128 + dp), a1 = *(const u32x4*)(prow + PBQ + h * 128 + dp + 8);
                  const u32x4 b0 = *(const u32x4*)(prow + PBK + h * 128 + dp), b1 = *(const u32x4*)(prow + PBK + h * 128 + dp + 8);
                  const unsigned aw[8] = {a0.x, a0.y, a0.z, a0.w, a1.x, a1.y, a1.z, a1.w}, bw[8] = {b0.x, b0.y, b0.z, b0.w, b1.x, b1.y, b1.z, b1.w};
#pragma unroll
                  for (int i = 0; i < 8; ++i) { qp[2 * i] = bflo(aw[i]); qp[2 * i + 1] = bfhi(aw[i]); kp2[2 * i] = bflo(bw[i]); kp2[2 * i + 1] = bfhi(bw[i]); } }
                const float posf = (float)((d0 < 64) ? (tl >> 6) : (tl & 63)); const bool second = (d0 & 32) != 0; const int f0 = d0 & 31;
#pragma unroll
                for (int i = 0; i < 16; ++i) { const float inv = __expf(-(float)(2 * (f0 + i)) * (9.210340371976184f / 64.0f)); const float ang = posf * inv; float sn, cn; __sincosf(ang, &sn, &cn);
                    const float q1 = second ? qp[i] : qv[i], q2 = second ? qv[i] : qp[i], k1 = second ? kp2[i] : kv[i], k2 = second ? kv[i] : kp2[i];
                    qv[i] = second ? (q1 * sn + q2 * cn) : (q1 * cn - q2 * sn); kv[i] = second ? (k1 * sn + k2 * cn) : (k1 * cn - k2 * sn); }
            }
            float lr[16];
            { const float4* lp = (const float4*)(LR + tok * 32 + dir * 16);
#pragma unroll
              for (int i = 0; i < 4; ++i) { const float4 t4 = lp[i]; lr[4 * i] = t4.x; lr[4 * i + 1] = t4.y; lr[4 * i + 2] = t4.z; lr[4 * i + 3] = t4.w; } }
            unsigned qe[8], ke[8]; float klv[16];
#pragma unroll
            for (int i = 0; i < 16; ++i) { float g = BG[d0 + i];
#pragma unroll
                for (int rr = 0; rr < 16; ++rr) g += lr[rr] * WG[rr * 128 + d0 + i];
                float la = -(fmaxf(-g, 0.f) + __logf(1.0f + __expf(-fabsf(g)))) * (1.0f / 16.0f);
#pragma unroll
                for (int off = 1; off < 64; off <<= 1) { const float t_ = __shfl_up(la, off); if (lane >= off) la += t_; }
                const float bl = __shfl(la, 63);
                const float eb = __expf(la), enb = __expf(-la), elb = __expf(bl - la);
                const float qq = qv[i] * ATT_SCALE * eb, kk = kv[i] * enb; klv[i] = kv[i] * elb;
                if (i & 1) { qe[i >> 1] = cvt_pk_bf16(__uint_as_float(qe[i >> 1]), qq); ke[i >> 1] = cvt_pk_bf16(__uint_as_float(ke[i >> 1]), kk); }
                else { qe[i >> 1] = __float_as_uint(qq); ke[i >> 1] = __float_as_uint(kk); }
                if (lane == 63) BL[d0 + i] = __expf(bl);
                KLT[(d0 + i) * 72 + lane] = f2bf(klv[i]); }
            { u32x4 w0, w1; w0.x = qe[0]; w0.y = qe[1]; w0.z = qe[2]; w0.w = qe[3]; w1.x = qe[4]; w1.y = qe[5]; w1.z = qe[6]; w1.w = qe[7];
              *(LAS u32x4*)(QE + lane * 136 + d0) = w0; *(LAS u32x4*)(QE + lane * 136 + d0 + 8) = w1;
              w0.x = ke[0]; w0.y = ke[1]; w0.z = ke[2]; w0.w = ke[3]; w1.x = ke[4]; w1.y = ke[5]; w1.z = ke[6]; w1.w = ke[7];
              *(LAS u32x4*)(KE + lane * 136 + d0) = w0; *(LAS u32x4*)(KE + lane * 136 + d0 + 8) = w1; }
            { const u32x4 v8 = *(const u32x4*)(prow + PBV + h * 256 + sl * 64 + w * 8); const unsigned vw[4] = {v8.x, v8.y, v8.z, v8.w};
#pragma unroll
              for (int i = 0; i < 4; ++i) { VTs[(w * 8 + 2 * i) * 72 + lane] = (bf16_t)(vw[i] & 0xffffu); VTs[(w * 8 + 2 * i + 1) * 72 + lane] = (bf16_t)(vw[i] >> 16); } }
        }
        __syncthreads();
        f32x4 cst[4];
#pragma unroll
        for (int x = 0; x < 2; ++x) { const int id = 2 * w + x, it = id >> 2, jt = id & 3; f32x4 a = {0.f, 0.f, 0.f, 0.f};
#pragma unroll
            for (int ks = 0; ks < 4; ++ks) a = mfma16(*(const LAS bf16x8*)(QE + (it * 16 + r) * 136 + ks * 32 + qd * 8), *(const LAS bf16x8*)(KE + (jt * 16 + r) * 136 + ks * 32 + qd * 8), a);
#pragma unroll
            for (int jj = 0; jj < 4; ++jj) { const int i = it * 16 + qd * 4 + jj, j = jt * 16 + r; ATT[i * 72 + j] = f2bf(i >= j ? a[jj] : 0.f); } }
#pragma unroll
        for (int et = 0; et < 4; ++et) { f32x4 a = {0.f, 0.f, 0.f, 0.f};
#pragma unroll
            for (int ks = 0; ks < 2; ++ks) a = mfma16(*(const LAS bf16x8*)(KLT + (w * 16 + r) * 72 + ks * 32 + qd * 8), *(const LAS bf16x8*)(VTs + (et * 16 + r) * 72 + ks * 32 + qd * 8), a);
            cst[et] = a; }
        __syncthreads();
#pragma unroll
        for (int x = 0; x < 2; ++x) { const int id = 2 * w + x, it = id >> 2, et = id & 3; f32x4 a = {0.f, 0.f, 0.f, 0.f};
#pragma unroll
            for (int ks = 0; ks < 2; ++ks) a = mfma16(*(const LAS bf16x8*)(ATT + (it * 16 + r) * 72 + ks * 32 + qd * 8), *(const LAS bf16x8*)(VTs + (et * 16 + r) * 72 + ks * 32 + qd * 8), a);
#pragma unroll
            for (int ks = 0; ks < 4; ++ks) a = mfma16(*(const LAS bf16x8*)(QE + (it * 16 + r) * 136 + ks * 32 + qd * 8), *(const LAS bf16x8*)(ST + (et * 16 + r) * 136 + ks * 32 + qd * 8), a);
#pragma unroll
            for (int jj = 0; jj < 4; ++jj) { const int pos = c * 64 + it * 16 + qd * 4 + jj; const int tl = dir ? (L - 1 - pos) : pos;
                OG[(size_t)(tok0 + tl) * 1024 + h * 256 + sl * 64 + et * 16 + r] = a[jj]; } }
        __syncthreads();
#pragma unroll
        for (int et = 0; et < 4; ++et) {
#pragma unroll
            for (int jj = 0; jj < 4; ++jj) S[et][jj] = BL[w * 16 + qd * 4 + jj] * S[et][jj] + cst[et][jj];
            u32x2 wv; wv.x = cvt_pk_bf16(S[et][0], S[et][1]); wv.y = cvt_pk_bf16(S[et][2], S[et][3]); *(LAS u32x2*)(ST + (et * 16 + r) * 136 + w * 16 + qd * 4) = wv; }
        __syncthreads();
    }
    if (!latent) { float* so = p.out + OUT_S;
#pragma unroll
        for (int et = 0; et < 4; ++et)
#pragma unroll
            for (int jj = 0; jj < 4; ++jj) so[sidx + (size_t)jj * 256 + et * 16] = S[et][jj]; }
}

__device__ __forceinline__ void conv_item(const Params p, int l, int item, LAS unsigned char* lds) {
    const int tid = otid(), wid = tid >> 6, lane = tid & 63; const int R0 = item * 16;
    const int s0 = R0 < T_CTX ? (R0 & ~255) : T_CTX + ((R0 - T_CTX) & ~2047), s1 = s0 + (R0 < T_CTX ? 256 : 2048);
    const bf16_t* P = (const bf16_t*)(p.ws + WS_P); bf16_t* YC = (bf16_t*)(p.ws + WS_YCAT) + 2ull * T_ALL * 1024;
    LAS bf16_t* U = (LAS bf16_t*)lds;
    LAS float* RED = (LAS float*)(lds + 94208);
    LAS float* STAT = (LAS float*)(lds + 94208 + 1024);
    for (int i = tid; i < 46 * 128; i += 512) { const int s = i >> 7, c8 = (i & 127) * 8; const int row = R0 - 15 + s; u32x4 w = {0u, 0u, 0u, 0u};
        if (row >= s0 && row < s1) { const u32x4 a = *(const u32x4*)(P + (size_t)row * NP + PCU + c8), g = *(const u32x4*)(P + (size_t)row * NP + PCG + c8);
            w.x = cvt_pk_bf16(bflo(a.x) * sigmoidf_(bflo(g.x)), bfhi(a.x) * sigmoidf_(bfhi(g.x))); w.y = cvt_pk_bf16(bflo(a.y) * sigmoidf_(bflo(g.y)), bfhi(a.y) * sigmoidf_(bfhi(g.y)));
            w.z = cvt_pk_bf16(bflo(a.z) * sigmoidf_(bflo(g.z)), bfhi(a.z) * sigmoidf_(bfhi(g.z))); w.w = cvt_pk_bf16(bflo(a.w) * sigmoidf_(bflo(g.w)), bfhi(a.w) * sigmoidf_(bfhi(g.w))); }
        *(LAS u32x4*)(U + s * 1024 + c8) = w; }
    const int ch = tid * 2;
    float w0[31], w1[31];
#pragma unroll
    for (int j = 0; j < 31; ++j) { const float2 ww = *(const float2*)(p.conv_w + ((size_t)l * 31 + j) * 1024 + ch); w0[j] = ww.x; w1[j] = ww.y; }
    const float2 cb = *(const float2*)(p.conv_b + (size_t)l * 1024 + ch);
    float a0[16], a1[16];
#pragma unroll
    for (int t = 0; t < 16; ++t) { a0[t] = cb.x; a1[t] = cb.y; }
    __syncthreads();
#pragma unroll
    for (int s = 0; s < 46; ++s) { const unsigned uu = *(const LAS unsigned*)(U + s * 1024 + ch); const float u0 = bflo(uu), u1 = bfhi(uu);
#pragma unroll
        for (int t = 0; t < 16; ++t) { const int j = s - t; if (j >= 0 && j <= 30) { a0[t] += u0 * w0[j]; a1[t] += u1 * w1[j]; } } }
#pragma unroll
    for (int t = 0; t < 16; ++t) { const float sm = wsum(a0[t] + a1[t]), sq = wsum(a0[t] * a0[t] + a1[t] * a1[t]); if (lane == 0) { RED[(wid * 16 + t) * 2] = sm; RED[(wid * 16 + t) * 2 + 1] = sq; } }
    __syncthreads();
    if (tid < 16) { float sm = 0.f, sq = 0.f;
#pragma unroll
        for (int ww = 0; ww < 8; ++ww) { sm += RED[(ww * 16 + tid) * 2]; sq += RED[(ww * 16 + tid) * 2 + 1]; }
        const float mean = sm * (1.0f / 1024.0f), var = fmaxf(sq * (1.0f / 1024.0f) - mean * mean, 0.f); STAT[tid * 2] = mean; STAT[tid * 2 + 1] = rsqrtf(var + 1e-5f); }
    __syncthreads();
    const float2 gn = *(const float2*)(p.conv_norm_g + (size_t)l * 1024 + ch), bn = *(const float2*)(p.conv_norm_b + (size_t)l * 1024 + ch);
#pragma unroll
    for (int t = 0; t < 16; ++t) { const float mean = STAT[t * 2], rstd = STAT[t * 2 + 1]; const size_t row = (size_t)(R0 + t);
        const unsigned zz = *(const unsigned*)(P + row * NP + PCZ + ch);
        const float y0 = (a0[t] - mean) * rstd * gn.x + bn.x, y1 = (a1[t] - mean) * rstd * gn.y + bn.y;
        *(unsigned*)(YC + row * 1024 + ch) = cvt_pk_bf16(siluf_(y0) * siluf_(bflo(zz)), siluf_(y1) * siluf_(bfhi(zz))); }
}

__device__ __forceinline__ void mix_phase(const Params p, int l, LAS unsigned char* lds) {
    const int tid = otid(), w = tid >> 6;
    unsigned* ctr = (unsigned*)(p.ws + WS_CTL) + l; volatile LAS int* slot = (volatile LAS int*)(lds + LDS_CTL);
    constexpr int N_GL = 64, N_AC = 512, N_NA = 256, N_GC = 1024, N_CV = 768, N_ALL = N_GL + N_AC + N_NA + N_GC + N_CV;
    for (;;) {
        __syncthreads();
        if (tid == 0) *slot = (int)atomicAdd(ctr, 1u);
        __syncthreads();
        int a = *slot;
        if (a >= N_ALL) break;
#ifndef SK_GLA
        if (a < N_GL) { gla_item(p, l, true, a >> 5, (a >> 3) & 3, (a >> 2) & 1, a & 3, lds); continue; }
#endif
        a -= N_GL;
#ifndef SK_ATT
        if (a < N_AC) { const int bh = a >> 1, half = a & 1, b = bh >> 3, h = bh & 7; att_wave(p, l, false, b, h, b * 256 + (half * 8 + w) * 16, 0, 0); continue; }
        a -= N_AC;
        if (a < N_NA) { const int b = a >> 7, h = (a >> 4) & 7, row = (a & 15) * 2 + (w >> 2), t16 = w & 3; att_wave(p, l, true, b, h, T_CTX + b * 2048 + row * 64 + t16 * 16, row, t16); continue; }
#endif
        a -= N_NA;
#ifndef SK_GLA
        if (a < N_GC) { gla_item(p, l, false, a >> 5, (a >> 3) & 3, (a >> 2) & 1, a & 3, lds); continue; }
#endif
        a -= N_GC;
#ifndef SK_CONV
        conv_item(p, l, a, lds);
#endif
    }
}

__device__ __forceinline__ void post_phase(const Params p, int l) {
    const int tid = otid(), wid = tid >> 6, lane = tid & 63;
    const bf16_t* P = (const bf16_t*)(p.ws + WS_P); const float* OG = (const float*)(p.ws + WS_OG); bf16_t* YB = (bf16_t*)(p.ws + WS_YCAT) + 1ull * T_ALL * 1024;
    for (int tok = blockIdx.x * 8 + wid; tok < T_ALL; tok += gridDim.x * 8) { const bf16_t* prow = P + (size_t)tok * NP;
#pragma unroll
        for (int h = 0; h < 4; ++h) {
            const unsigned q2 = *(const unsigned*)(prow + PBQ + h * 128 + lane * 2), k2 = *(const unsigned*)(prow + PBK + h * 128 + lane * 2);
            const float qk = wsum(bflo(q2) * bflo(k2) + bfhi(q2) * bfhi(k2)) * ATT_SCALE;
            const int e = h * 256 + lane * 4;
            const f32x4 of = *(const f32x4*)(OG + (size_t)tok * 1024 + e), ob = *(const f32x4*)(OG + (size_t)(T_ALL + tok) * 1024 + e);
            const u32x2 v2 = *(const u32x2*)(prow + PBV + e), z2 = *(const u32x2*)(prow + PBZ + e);
            f32x4 o; o[0] = of[0] + ob[0] - qk * bflo(v2.x); o[1] = of[1] + ob[1] - qk * bfhi(v2.x); o[2] = of[2] + ob[2] - qk * bflo(v2.y); o[3] = of[3] + ob[3] - qk * bfhi(v2.y);
            const float rs = rsqrtf(wsum((o[0] * o[0] + o[1] * o[1]) + (o[2] * o[2] + o[3] * o[3])) * (1.0f / 256.0f) + 1e-5f);
            const f32x4 g = *(const f32x4*)(p.gla_norm_g + (size_t)l * 1024 + e);
            u32x2 wv; wv.x = cvt_pk_bf16(o[0] * rs * g[0] * siluf_(bflo(z2.x)), o[1] * rs * g[1] * siluf_(bfhi(z2.x))); wv.y = cvt_pk_bf16(o[2] * rs * g[2] * siluf_(bflo(z2.y)), o[3] * rs * g[3] * siluf_(bfhi(z2.y)));
            *(u32x2*)(YB + (size_t)tok * 1024 + e) = wv; } }
}

#define GRID_SYNC() do { __builtin_amdgcn_fence(__ATOMIC_RELEASE, "agent"); grid.sync(); __builtin_amdgcn_fence(__ATOMIC_ACQUIRE, "agent"); asm volatile("s_waitcnt vmcnt(0)" ::: "memory"); } while (0)
__global__ void __launch_bounds__(512, 2) fwd_megakernel(Params p) {
    extern __shared__ __attribute__((aligned(16))) unsigned char smem[];
    LAS unsigned char* lds = (LAS unsigned char*)smem;
    cg::grid_group grid = cg::this_grid();
    unsigned char* ws = p.ws; const int c = blockIdx.x;
#ifndef SK_P0
    phase0(p, lds);
#endif
    GRID_SYNC();
    phase0b(p);
    GRID_SYNC();
    for (int l = 0; l < 2; ++l) {
#ifndef SK_LN
        if (l == 0) ln_phase<0>(p, 0); else ln_phase<1>(p, 1);
#endif
        GRID_SYNC();
#ifndef SK_LR
        lr_phase(p, l);
#endif
#ifndef SK_IN
        { Gemm g; g.A = (const bf16_t*)(ws + WS_H); g.Bt = (const bf16_t*)(ws + WS_BTIN) + (size_t)l * 16416 * 2048; g.M = T_ALL; g.N = NP; g.K = DM;
          StaticOrder so; so.init(T_ALL, NP, gridDim.x, c);
          EpiIn e; e.P = (bf16_t*)(ws + WS_P); e.newk = p.out + OUT_K; e.l = l;
          pg8::gemm_phase<EpiIn, StaticOrder>(lds, g, so, e, nullptr); }
        { Gemm g; g.A = (const bf16_t*)(ws + WS_BTIN) + ((size_t)l * 16416 + 15360) * 2048; g.Bt = (const bf16_t*)(ws + WS_H); g.M = 1024; g.N = T_ALL; g.K = DM;
          StaticOrder so; so.init(1024, T_ALL, gridDim.x, (c + gridDim.x - 64) % gridDim.x);
          EpiV e; e.VT = (bf16_t*)(ws + WS_VT); e.newv = p.out + OUT_V; e.l = l;
          pg8::gemm_phase<EpiV, StaticOrder>(lds, g, so, e, nullptr); }
#endif
        GRID_SYNC();
#ifndef SK_MIX
        mix_phase(p, l, lds);
#endif
        GRID_SYNC();
#ifndef SK_POST
        post_phase(p, l);
#endif
#ifndef SK_BR
        GRID_SYNC();
        { Gemm g; g.A = (const bf16_t*)(ws + WS_YCAT); g.Bt = (const bf16_t*)(ws + WS_BTBR) + (size_t)l * 6144 * 1024; g.M = 3 * T_ALL; g.N = 3 * DM; g.K = 1024;
          BrOrder bo; bo.so.init(T_ALL, DM, gridDim.x, c);
          EpiBr e; e.P = (const bf16_t*)(ws + WS_P); e.M32 = (float*)(ws + WS_OG); e.MRG = (bf16_t*)(ws + WS_MRG);
          pg8::gemm_phase<EpiBr, BrOrder>(lds, g, bo, e, nullptr); }
#endif
        GRID_SYNC();
        { Gemm g; g.A = (const bf16_t*)(ws + WS_MRG); g.Bt = (const bf16_t*)(ws + WS_BTOUT) + (size_t)l * DM * DM; g.M = T_ALL; g.N = DM; g.K = DM;
#ifndef SK_OUT
          StaticOrder so; so.init(T_ALL, DM, gridDim.x, c);
          EpiOut e; e.xp = p.x_prompt; e.xs = p.x_sample; e.x1 = (const float*)(ws + WS_X1); e.mod = (const float*)(ws + WS_MOD); e.Z = (float*)(ws + WS_P); e.l = l;
          pg8::gemm_phase<EpiOut, StaticOrder>(lds, g, so, e, nullptr);
#endif
        }
        GRID_SYNC();
    }
    ln_phase<2>(p, 2);
}
}

extern "C" void kernel_launch(void* const* d_in, const int* in_sizes, int n_in, void* d_out, int out_size, void* d_ws, size_t ws_size, hipStream_t stream) {
    static int grid_blocks = 0;
    if (!grid_blocks) {
        int dev = 0, cus = 0, per_cu = 0;
        (void)hipGetDevice(&dev);
        (void)hipDeviceGetAttribute(&cus, hipDeviceAttributeMultiprocessorCount, dev);
        (void)hipFuncSetAttribute((const void*)mk::fwd_megakernel, hipFuncAttributeMaxDynamicSharedMemorySize, mk::LDS_BYTES);
        (void)hipOccupancyMaxActiveBlocksPerMultiprocessor(&per_cu, (const void*)mk::fwd_megakernel, 512, mk::LDS_BYTES);
        if (per_cu < 1) per_cu = 1;
        grid_blocks = cus * per_cu;
        if (ws_size < mk::WS_END || n_in != 24) fprintf(stderr, "kernel_launch: workspace %zu < %zu or n_in %d != 24\n", ws_size, (size_t)mk::WS_END, n_in);
    }
    mk::Params p{};
    const float** pp = (const float**)&p;
    for (int i = 0; i < 24; ++i) pp[i] = (const float*)d_in[i];
    p.out = (float*)d_out; p.ws = (unsigned char*)d_ws;
    void* args[] = {&p};
    hipError_t e = hipLaunchCooperativeKernel((void*)mk::fwd_megakernel, dim3(grid_blocks), dim3(512), args, mk::LDS_BYTES, stream);
    if (e != hipSuccess) fprintf(stderr, "cooperative launch failed: %s (grid %d)\n", hipGetErrorString(e), grid_blocks);
}
```

```cpp
#include <hip/hip_runtime.h>
#include <hip/hip_cooperative_groups.h>
#include <cstdio>
namespace cg = cooperative_groups;
namespace pg8 {
#define PG8_LAS __attribute__((address_space(3)))
typedef unsigned short bf16_t;
typedef short bf16x8 __attribute__((ext_vector_type(8)));
typedef float f32x4 __attribute__((ext_vector_type(4)));
typedef unsigned u32x4 __attribute__((ext_vector_type(4)));
constexpr int BM = 256, BK = 64, HALF = 128, HTB = HALF * BK * 2  , STAGE_BYTES = 8 * HTB, NXCD = 8, WGM = 8;

__host__ __device__ __forceinline__ int lds_byte(int r, int c) { const int st = (r >> 4) * 2 + (c >> 5), rr = r & 15, cc = c & 31, ob = rr * 64 + cc * 2; return st * 1024 + (ob ^ (((ob >> 9) & 1) << 5)); }
__host__ __device__ __forceinline__ void stage_rc(int b, int& R, int& C) { const int st = b / 1024, sb = b % 1024, swz = sb ^ (((sb >> 9) & 1) << 5); R = (st >> 1) * 16 + swz / 64; C = (st & 1) * 32 + (swz % 64) / 2; }
__host__ __device__ __forceinline__ int perm32(int rho) { const int n = rho >> 4, i = rho & 15; return 8 * (i >> 2) + 4 * n + (i & 3); }

typedef short s16x16_cat __attribute__((ext_vector_type(16))); typedef int v8i_cat __attribute__((ext_vector_type(8)));
__device__ __forceinline__ v8i_cat cat16(bf16x8 a, bf16x8 b) { const s16x16_cat t = __builtin_shufflevector(a, b, 0, 1, 2, 3, 4, 5, 6, 7, 8, 9, 10, 11, 12, 13, 14, 15); return __builtin_bit_cast(v8i_cat, t); }
template <bool F8> struct Frag;
template <> struct Frag<false> { bf16x8 k[2]; };
template <> struct Frag<true> { v8i_cat v; };
struct Unit { int pm, pn; };
struct Gemm { const bf16_t* A; const bf16_t* Bt; int M, N, K; };

struct StaticOrder {
    int nM, nN, nwg, G, c;
    __host__ __device__ void init(int M, int N, int G_, int c_) { nM = M / BM; nN = N / BM; nwg = nM * nN; G = G_; c = c_; }
    __host__ __device__ bool next(int i, Unit& u) const {
        const long L = (long)i * G + c; if (L >= nwg) return false;
        int wgid = (int)L; { const int q = nwg / NXCD, r = nwg % NXCD, xcd = wgid % NXCD, off = wgid / NXCD; wgid = (xcd < r ? xcd * (q + 1) : r * (q + 1) + (xcd - r) * q) + off; }
        const int nig = WGM * nN, gid = wgid / nig, fm = gid * WGM, gsz = (nM - fm) < WGM ? (nM - fm) : WGM;
        u.pm = fm + ((wgid % nig) % gsz); u.pn = (wgid % nig) / gsz; return true;
    }
    __device__ __forceinline__ void a_ready(const Unit&) const {}
    __device__ __forceinline__ void done(const Unit&) const {}
};
typedef float f32x2_cv __attribute__((ext_vector_type(2))); typedef __bf16 bf16x2_cv __attribute__((ext_vector_type(2)));
__device__ __forceinline__ unsigned cvt_pk_bf16(float lo, float hi) { const f32x2_cv v = {lo, hi}; return __builtin_bit_cast(unsigned, __builtin_convertvector(v, bf16x2_cv)); }
template <class Epi, class Sched, bool STAMP = false>
__device__ __forceinline__ void gemm_phase(PG8_LAS unsigned char* lds, const Gemm g, const Sched& S, const Epi& E, unsigned long long* stamps) {
    int tid_ = threadIdx.x; asm volatile("" : "+v"(tid_)); const int tid = tid_, wid = __builtin_amdgcn_readfirstlane(tid >> 6), lane = tid & 63, wr = wid >> 2, wc = wid & 3, fr = lane & 15, fq = lane >> 4;
    const int K = g.K, nt = K / BK;
    int ts_lo = 0, ts_hi = 0, nts = 0; const unsigned long long rt_entry = STAMP ? (unsigned long long)wall_clock64() : 0ull;
#define PG8_STAMP() do { if (STAMP && wid == 0 && nts < 64) { const unsigned long long _c = (unsigned long long)clock64(); \
        ts_lo = (lane == nts) ? (int)(unsigned)_c : ts_lo; ts_hi = (lane == nts) ? (int)(unsigned)(_c >> 32) : ts_hi; ++nts; } } while (0)
    PG8_STAMP();
    unsigned voffA[2], voffB[2];
#pragma unroll
    for (int i = 0; i < 2; ++i) { int R, C; stage_rc(tid * 16 + i * 8192, R, C); const int Rb = Epi::PERM ? ((R & ~31) + perm32(R & 31)) : R;
        voffA[i] = (unsigned)(R * K + C) * 2u; voffB[i] = (unsigned)(Rb * K + C) * 2u; }
    const size_t kstep = (size_t)(BK * 2);
    const size_t hstep = (size_t)HALF * K * 2;
    const size_t tstep = 2 * hstep;
    const unsigned ldsw = (unsigned)wid * 1024u;
    const int aoff = lds_byte(wr * 64 + fr, fq * 8), boff = lds_byte(wc * 32 + fr, fq * 8);
#define PG8_SA(b, h) (((b) * 2 + (h)) * HTB)
#define PG8_SB(b, h) ((4 + (b) * 2 + (h)) * HTB)
#define PG8_STAGE(bufoff, gbase, voff) do { _Pragma("unroll") for (int _i = 0; _i < 2; ++_i) { unsigned vo_ = (voff)[_i]; asm volatile("" : "+v"(vo_)); \
        __builtin_amdgcn_global_load_lds((const unsigned*)((const char*)(gbase) + vo_), (PG8_LAS unsigned*)(lds + (bufoff) + ldsw + _i * 8192), 16, 0, 0); } } while (0)
#define PG8_LD1(off) (*(const PG8_LAS bf16x8*)(lds + (off)))
#define PG8_LDA(dst, b, h) do { _Pragma("unroll") for (int m = 0; m < 4; ++m) { const int o_ = PG8_SA(b, h) + aoff + m * 2048; \
        if constexpr (Epi::FP8) dst[m].v = cat16(PG8_LD1(o_), PG8_LD1(o_ + 1024)); else { dst[m].k[0] = PG8_LD1(o_); dst[m].k[1] = PG8_LD1(o_ + 1024); } } } while (0)
#define PG8_LDB(dst, b, h) do { _Pragma("unroll") for (int n = 0; n < 2; ++n) { const int o_ = PG8_SB(b, h) + boff + n * 2048; \
        if constexpr (Epi::FP8) dst[n].v = cat16(PG8_LD1(o_), PG8_LD1(o_ + 1024)); else { dst[n].k[0] = PG8_LD1(o_); dst[n].k[1] = PG8_LD1(o_ + 1024); } } } while (0)
#define PG8_MMA(ai, bj, At, Bt) do { __builtin_amdgcn_s_setprio(1); _Pragma("unroll") for (int m = 0; m < 4; ++m) _Pragma("unroll") for (int n = 0; n < 2; ++n) { \
        if constexpr (Epi::FP8) asm volatile("v_mfma_f32_16x16x128_f8f6f4 %0, %1, %2, %0" : "+v"(acc[ai][bj][m][n]) : "v"(Bt[n].v), "v"(At[m].v));   \
        else { _Pragma("unroll") for (int k = 0; k < 2; ++k) acc[ai][bj][m][n] = __builtin_amdgcn_mfma_f32_16x16x32_bf16(Bt[n].k[k], At[m].k[k], acc[ai][bj][m][n], 0, 0, 0); } } \
        __builtin_amdgcn_s_setprio(0); } while (0)
#define PG8_WAIT_V(n) asm volatile("s_waitcnt vmcnt(" #n ")" ::: "memory")
#define PG8_WAIT_L(n) asm volatile("s_waitcnt lgkmcnt(" #n ")" ::: "memory")
#define PG8_BAR __builtin_amdgcn_s_barrier()
#define PG8_SCHED __builtin_amdgcn_sched_barrier(0)
    Unit cur, nxt; int ui = 0;
    if (!S.next(0, cur)) return;
    f32x4 acc[2][2][4][2];
#pragma unroll
    for (int a = 0; a < 2; ++a)
#pragma unroll
        for (int b = 0; b < 2; ++b)
#pragma unroll
            for (int m = 0; m < 4; ++m)
#pragma unroll
                for (int n = 0; n < 2; ++n) acc[a][b][m][n] = (f32x4){0.f, 0.f, 0.f, 0.f};
    Frag<Epi::FP8> At[4], B0[2], B1[2];
    const char* cA = (const char*)g.A + (size_t)cur.pm * tstep; const char* cB = (const char*)g.Bt + (size_t)cur.pn * tstep;
    S.a_ready(cur);
    PG8_STAGE(PG8_SB(0, 0), cB, voffB); PG8_STAGE(PG8_SA(0, 0), cA, voffA); PG8_STAGE(PG8_SB(0, 1), cB + hstep, voffB); PG8_STAGE(PG8_SA(0, 1), cA + hstep, voffA);
    if (wr == 1) PG8_BAR;
    PG8_WAIT_V(4); PG8_BAR;
    PG8_STAGE(PG8_SB(1, 0), cB + kstep, voffB); PG8_STAGE(PG8_SA(1, 0), cA + kstep, voffA); PG8_STAGE(PG8_SB(1, 1), cB + hstep + kstep, voffB);
    PG8_WAIT_V(6); PG8_BAR;
    PG8_STAMP();
    for (;;) {
        const bool has_next = S.next(ui + 1, nxt);
        const char* nA = has_next ? (const char*)g.A + (size_t)nxt.pm * tstep : cA; const char* nB = has_next ? (const char*)g.Bt + (size_t)nxt.pn * tstep : cB;
        for (int t = 0; t < nt; t += 2) {
            const bool last = (t == nt - 2);
            const char* a1 = cA + (size_t)(t + 1) * kstep;
            const char* a2 = last ? nA : cA + (size_t)(t + 2) * kstep; const char* b2 = last ? nB : cB + (size_t)(t + 2) * kstep;
            const char* a3 = a2 + kstep; const char* b3 = b2 + kstep;
            if (last && has_next) S.a_ready(nxt);
            PG8_LDB(B0, 0, 0); PG8_SCHED; PG8_LDA(At, 0, 0); PG8_STAGE(PG8_SA(1, 1), a1 + hstep, voffA);
            PG8_WAIT_L(8); PG8_BAR; PG8_WAIT_L(0); PG8_MMA(0, 0, At, B0); PG8_BAR; PG8_SCHED;
            PG8_LDB(B1, 0, 1); PG8_STAGE(PG8_SB(0, 0), b2, voffB);
            PG8_BAR; PG8_WAIT_L(0); PG8_MMA(0, 1, At, B1); PG8_BAR;
            PG8_LDA(At, 0, 1); PG8_STAGE(PG8_SA(0, 0), a2, voffA);
            PG8_BAR; PG8_WAIT_L(0); PG8_MMA(1, 0, At, B0); PG8_BAR; PG8_SCHED;
            PG8_STAGE(PG8_SB(0, 1), b2 + hstep, voffB);
            PG8_WAIT_V(6); PG8_BAR; PG8_MMA(1, 1, At, B1); PG8_BAR;
            PG8_LDB(B0, 1, 0); PG8_SCHED; PG8_LDA(At, 1, 0); PG8_STAGE(PG8_SA(0, 1), a2 + hstep, voffA);
            PG8_WAIT_L(8); PG8_BAR; PG8_WAIT_L(0); PG8_MMA(0, 0, At, B0); PG8_BAR; PG8_SCHED;
            PG8_LDB(B1, 1, 1); PG8_STAGE(PG8_SB(1, 0), b3, voffB);
            PG8_BAR; PG8_WAIT_L(0); PG8_MMA(0, 1, At, B1); PG8_BAR;
            PG8_LDA(At, 1, 1); PG8_STAGE(PG8_SA(1, 0), a3, voffA);
            PG8_BAR; PG8_WAIT_L(0); PG8_MMA(1, 0, At, B0); PG8_BAR; PG8_SCHED;
            PG8_STAGE(PG8_SB(1, 1), b3 + hstep, voffB);
            PG8_WAIT_V(6); PG8_BAR; PG8_MMA(1, 1, At, B1); PG8_BAR;
        }
        PG8_STAMP();
        if constexpr (Epi::FP8) asm volatile("s_nop 15\n\ts_nop 15\n\ts_nop 7" ::: "memory");
        if constexpr (!Epi::AFTER_DRAIN) { int te_ = threadIdx.x; asm volatile("" : "+v"(te_));
            const int fre_ = te_ & 15, fqe_ = (te_ & 63) >> 4; E(acc, cur, wr, wc, fre_, fqe_); S.done(cur); }
        PG8_STAMP();
        if (!has_next) break;
#pragma unroll
        for (int a = 0; a < 2; ++a)
#pragma unroll
            for (int b = 0; b < 2; ++b)
#pragma unroll
                for (int m = 0; m < 4; ++m)
#pragma unroll
                    for (int n = 0; n < 2; ++n) acc[a][b][m][n] = (f32x4){0.f, 0.f, 0.f, 0.f};
        cur = nxt; cA = nA; cB = nB; ++ui;
    }
    PG8_WAIT_V(0);
    if (wr == 0) PG8_BAR;
    PG8_BAR;
    if constexpr (Epi::AFTER_DRAIN) { E.fused(acc, cur, wr, wc, fr, fq, lds, wid, lane); S.done(cur); }
    PG8_STAMP();
    if (STAMP && wid == 0) { stamps[lane] = lane < nts ? (((unsigned long long)(unsigned)ts_hi << 32) | (unsigned)ts_lo) : 0ull;
        if (lane == 62) stamps[62] = rt_entry; if (lane == 63) stamps[63] = (unsigned long long)wall_clock64(); }
#undef PG8_STAMP
#undef PG8_SA
#undef PG8_SB
#undef PG8_STAGE
#undef PG8_LD1
#undef PG8_LDA
#undef PG8_LDB
#undef PG8_MMA
#undef PG8_WAIT_V
#undef PG8_WAIT_L
#undef PG8_BAR
#undef PG8_SCHED
}
}

namespace mk {
using pg8::bf16_t; using pg8::bf16x8; using pg8::f32x4; using pg8::u32x4; using pg8::Unit; using pg8::Gemm; using pg8::StaticOrder; using pg8::cvt_pk_bf16;
#define LAS __attribute__((address_space(3)))
typedef short bf16x4 __attribute__((ext_vector_type(4)));
typedef unsigned u32x2 __attribute__((ext_vector_type(2)));

constexpr int T_ALL = 12288, T_CTX = 8192, DM = 2048, NP = 15360, NIN = 16416;
constexpr int PQ = 0, PK = 1024, PZA = 2048, PBQ = 3072, PBK = 3584, PBV = 4096, PBZ = 5120, PCU = 6144, PCG = 7168, PCZ = 8192, PGA = 9216, PGB = 11264, PGC = 13312;
constexpr float ATT_SCALE = 0.08838834764831845f;
constexpr float ALPHA_DN = 1.4142135623730951f;
constexpr size_t OUT_Y = 0, OUT_K = 25165824ull, OUT_V = 41943040ull, OUT_S = 58720256ull;

constexpr size_t WS_CTL = 0;
constexpr size_t WS_MOD = 16384;
constexpr size_t WS_BTIN = 16384 + 147456;
constexpr int CTL_Q = 3584;
constexpr int RB = 3616;
constexpr size_t WS_BTBR = WS_BTIN + 2ull * RB * 2048 * 2;
constexpr size_t WS_BTOUT = WS_BTBR + 2ull * 6144 * 1024 * 2;
constexpr size_t WS_CK = WS_BTOUT + 2ull * 2048 * 2048 * 2;
constexpr size_t WS_CVT = WS_CK + 4ull * 256 * 1024 * 2;
constexpr size_t WS_H = WS_CVT + 4ull * 256 * 1024 * 2;
constexpr size_t WS_VT = WS_H + 12288ull * 2048 * 2;
constexpr size_t WS_LR = WS_VT + 1024ull * 12288 * 2;
constexpr size_t WS_YCAT = WS_LR + 12288ull * 32 * 4;
constexpr size_t WS_MRG = WS_YCAT + 3ull * 12288 * 1024 * 2;
constexpr size_t WS_X1 = WS_MRG + 12288ull * 2048 * 2;
constexpr size_t WS_OG = WS_X1 + 12288ull * 2048 * 4;
constexpr size_t WS_P = WS_OG + 2ull * 12288 * 1024 * 4;
constexpr size_t WS_SM = WS_P + 12288ull * 15360 * 2;
constexpr int SM_RPB = 0, SM_WG = 7680, SM_BGT = SM_WG + 32768, SM_NG = SM_BGT + 2048, SM_CW = SM_NG + 2048, SM_CB = SM_CW + 63488, SM_CNG = SM_CB + 2048, SM_CNB = SM_CNG + 2048,
    SM_LNG = SM_CNB + 2048, SM_LNB = SM_LNG + 4096, SM_ST = SM_LNB + 4096, SM_END = SM_ST + 1048576;
constexpr size_t WS_GST = WS_SM + (size_t)SM_END * 4;
constexpr size_t WS_BT8 = WS_GST + 1536ull * 53760;
constexpr int R8 = 15360;
constexpr size_t WS_H8 = WS_BT8 + 2ull * R8 * 2048;
constexpr size_t WS_END = WS_H8 + 12288ull * 2048;
constexpr int LDS_BYTES = 131072 + 1024;
constexpr int LDS_CTL = 131072;

struct Params {
    const float *x_prompt, *x_sample, *cache_k, *cache_v, *state_gla, *c, *c_ctx, *w_mod, *b_mod, *w_in, *rpb, *gla_w_gate, *gla_b_gate, *gla_norm_g,
        *conv_w, *conv_b, *conv_norm_g, *conv_norm_b, *w_proj_a, *w_proj_b, *w_proj_c, *w_out, *ln_g, *ln_b;
    float* out; unsigned char* ws;
};

__device__ __forceinline__ int otid() { int t = threadIdx.x; asm volatile("" : "+v"(t)); return t; }
#define GAS __attribute__((address_space(1)))
__device__ __forceinline__ unsigned char* ows(const Params& p) { GAS unsigned char* w = (GAS unsigned char*)p.ws; asm volatile("" : "+s"(w)); return (unsigned char*)w; }
__device__ __forceinline__ float bf2f(bf16_t b) { return __uint_as_float(((unsigned)b) << 16); }
__device__ __forceinline__ float bflo(unsigned w) { return __uint_as_float(w << 16); }
__device__ __forceinline__ float bfhi(unsigned w) { return __uint_as_float(w & 0xffff0000u); }
__device__ __forceinline__ bf16_t f2bf(float f) { unsigned u = __float_as_uint(f); u += 0x7FFFu + ((u >> 16) & 1u); return (bf16_t)(u >> 16); }
__device__ __forceinline__ float sigmoidf_(float x) { return 1.0f / (1.0f + __expf(-x)); }
__device__ __forceinline__ float siluf_(float x) { return x / (1.0f + __expf(-x)); }
template <int O> __device__ __forceinline__ float sxor(float v) { return __builtin_bit_cast(float, __builtin_amdgcn_ds_swizzle(__builtin_bit_cast(int, v), (O << 10) | 0x1F)); }
__device__ __forceinline__ float bperm(float v, int byte_index) { return __builtin_bit_cast(float, __builtin_amdgcn_ds_bpermute(byte_index, __builtin_bit_cast(int, v))); }
__device__ __forceinline__ float rlane(float v, int l) { return __builtin_bit_cast(float, __builtin_amdgcn_readlane(__builtin_bit_cast(int, v), l)); }
__device__ __forceinline__ float wsum(float v) { v += sxor<16>(v); v += sxor<8>(v); v += sxor<4>(v); v += sxor<2>(v); v += sxor<1>(v); return rlane(v, 0) + rlane(v, 32); }
__device__ __forceinline__ f32x4 mfma16(bf16x8 a, bf16x8 b, f32x4 c) { return __builtin_amdgcn_mfma_f32_16x16x32_bf16(a, b, c, 0, 0, 0); }

template <int NW> __device__ __forceinline__ void tr_tile(const float* src, size_t ld, bf16_t* dst, size_t dstK, LAS float* t) {
    const int tid = otid();
    constexpr int TPR = NW / 4, RPP = 512 / TPR, S = NW + 1;
#pragma unroll
    for (int it = 0; it < 128 / RPP; ++it) { const int k = it * RPP + tid / TPR, n4 = (tid % TPR) * 4; const float4 v = *(const float4*)(src + (size_t)k * ld + n4);
        t[k * S + n4] = v.x; t[k * S + n4 + 1] = v.y; t[k * S + n4 + 2] = v.z; t[k * S + n4 + 3] = v.w; }
    __syncthreads();
#pragma unroll
    for (int ps = 0; ps < NW / 32; ++ps) { const int n = ps * 32 + (tid >> 4), k8 = (tid & 15) * 8; u32x4 w;
        w.x = cvt_pk_bf16(t[(k8 + 0) * S + n], t[(k8 + 1) * S + n]); w.y = cvt_pk_bf16(t[(k8 + 2) * S + n], t[(k8 + 3) * S + n]);
        w.z = cvt_pk_bf16(t[(k8 + 4) * S + n], t[(k8 + 5) * S + n]); w.w = cvt_pk_bf16(t[(k8 + 6) * S + n], t[(k8 + 7) * S + n]);
        *(u32x4*)(dst + (size_t)n * dstK + k8) = w; }
    __syncthreads();
}
__device__ __forceinline__ unsigned pk4_fp8(float a, float b_, float c_, float d) { int w = 0; w = __builtin_amdgcn_cvt_pk_fp8_f32(a, b_, w, false); w = __builtin_amdgcn_cvt_pk_fp8_f32(c_, d, w, true); return (unsigned)w; }
__device__ __forceinline__ void tr_tile8(const float* src, size_t ld, unsigned char* dst, size_t dstK, LAS float* t) {
    const int tid = otid(); constexpr int S = 129;
#pragma unroll
    for (int it = 0; it < 8; ++it) { const int k = it * 16 + (tid >> 5), n4 = (tid & 31) * 4; const float4 v = *(const float4*)(src + (size_t)k * ld + n4);
        t[k * S + n4] = v.x; t[k * S + n4 + 1] = v.y; t[k * S + n4 + 2] = v.z; t[k * S + n4 + 3] = v.w; }
    __syncthreads();
#pragma unroll
    for (int ps = 0; ps < 4; ++ps) { const int n = ps * 32 + (tid >> 4), k8 = (tid & 15) * 8; u32x2 w;
        w.x = pk4_fp8(64.f * t[(k8 + 0) * S + n], 64.f * t[(k8 + 1) * S + n], 64.f * t[(k8 + 2) * S + n], 64.f * t[(k8 + 3) * S + n]);
        w.y = pk4_fp8(64.f * t[(k8 + 4) * S + n], 64.f * t[(k8 + 5) * S + n], 64.f * t[(k8 + 6) * S + n], 64.f * t[(k8 + 7) * S + n]);
        *(u32x2*)(dst + (size_t)n * dstK + k8) = w; }
    __syncthreads();
}
__device__ __forceinline__ int win_row(int n, bool& is8) {
    is8 = true;
    if (n < 1024) return n;
    if (n < 2048) { is8 = false; return n - 1024; }
    if (n < 3072) { is8 = false; return 2560 + (n - 2048); }
    if (n < 4096) return 1024 + (n - 3072);
    if (n < 4608) return 2048 + (n - 4096);
    if (n < 5120) { is8 = false; return 1024 + (n - 4608); }
    if (n < 6144) { is8 = false; return 1536 + (n - 5120); }
    if (n < 6176) { is8 = false; return 3584 + (n - 6144); }
    return 2560 + (n - 6176);
}
__device__ __forceinline__ void phase0(const Params p, LAS unsigned char* lds) {
    const int tid = otid(); unsigned char* ws = ows(p);
    LAS float* t = (LAS float*)lds;
    bf16_t* btin = (bf16_t*)(ws + WS_BTIN); bf16_t* btbr = (bf16_t*)(ws + WS_BTBR); bf16_t* btout = (bf16_t*)(ws + WS_BTOUT); bf16_t* cvt = (bf16_t*)(ws + WS_CVT);
    float* modp = (float*)(ws + WS_P);
    constexpr int J_MOD = 256, J_WIN = 2 * 128 * 16, J_LRW = 2 * 16, J_WBR = 2 * 3 * 128, J_WOUT = 2 * 256, J_CV = 4 * 16;
    for (int j = blockIdx.x; j < J_MOD + J_WIN + J_LRW + J_WBR + J_WOUT + J_CV; j += gridDim.x) {
        int q = j;
        if (q < J_MOD) {
            const int l = q >> 7, slab = q & 127, k0 = slab * 16;
            float acc[3][12];
#pragma unroll
            for (int v = 0; v < 3; ++v)
#pragma unroll
                for (int i = 0; i < 12; ++i) acc[v][i] = 0.f;
            for (int kk = 0; kk < 16; ++kk) { const int k = k0 + kk;
                const float s0 = siluf_(p.c_ctx[k]), s1 = siluf_(p.c[k]), s2 = siluf_(p.c[2048 + k]);
                const float* wr_ = p.w_mod + ((size_t)l * 2048 + k) * 6144 + tid * 4;
#pragma unroll
                for (int jx = 0; jx < 3; ++jx) { const float4 w = *(const float4*)(wr_ + jx * 2048);
                    acc[0][jx * 4 + 0] += s0 * w.x; acc[0][jx * 4 + 1] += s0 * w.y; acc[0][jx * 4 + 2] += s0 * w.z; acc[0][jx * 4 + 3] += s0 * w.w;
                    acc[1][jx * 4 + 0] += s1 * w.x; acc[1][jx * 4 + 1] += s1 * w.y; acc[1][jx * 4 + 2] += s1 * w.z; acc[1][jx * 4 + 3] += s1 * w.w;
                    acc[2][jx * 4 + 0] += s2 * w.x; acc[2][jx * 4 + 1] += s2 * w.y; acc[2][jx * 4 + 2] += s2 * w.z; acc[2][jx * 4 + 3] += s2 * w.w; } }
#pragma unroll
            for (int v = 0; v < 3; ++v)
#pragma unroll
                for (int jx = 0; jx < 3; ++jx) { float4 o; o.x = acc[v][jx * 4]; o.y = acc[v][jx * 4 + 1]; o.z = acc[v][jx * 4 + 2]; o.w = acc[v][jx * 4 + 3];
                    *(float4*)(modp + ((size_t)(l * 128 + slab) * 3 + v) * 6144 + jx * 2048 + tid * 4) = o; }
            continue;
        }
        q -= J_MOD;
        if (q < J_WIN) { const int l = q >> 11, rem = q & 2047, nt = rem >> 4, kt = rem & 15, n0 = nt < 48 ? nt * 128 : 6176 + (nt - 48) * 128, k0 = kt * 128;
            bool is8; const int drow = win_row(n0, is8);
            if (is8) tr_tile8(p.w_in + ((size_t)l * 2048 + k0) * NIN + n0, NIN, ws + WS_BT8 + ((size_t)l * R8 + drow) * 2048 + k0, 2048, t);
            else { tr_tile<128>(p.w_in + ((size_t)l * 2048 + k0) * NIN + n0, NIN, btin + ((size_t)l * RB + drow) * 2048 + k0, 2048, t);
                if (drow < 2560) tr_tile8(p.w_in + ((size_t)l * 2048 + k0) * NIN + n0, NIN, ws + WS_BT8 + ((size_t)l * R8 + 12800 + drow) * 2048 + k0, 2048, t); }
            continue; }
        q -= J_WIN;
        if (q < J_LRW) { const int l = q >> 4, kt = q & 15, k0 = kt * 128;
            tr_tile<32>(p.w_in + ((size_t)l * 2048 + k0) * NIN + 6144, NIN, btin + ((size_t)l * RB + 3584) * 2048 + k0, 2048, t); continue; }
        q -= J_LRW;
        if (q < J_WBR) { const int l = q / 384, rem = q % 384, br = rem >> 7, r2 = rem & 127, nt = r2 >> 3, kt = r2 & 7, n0 = nt * 128, k0 = kt * 128;
            const float* w = (br == 0 ? p.w_proj_a : (br == 1 ? p.w_proj_b : p.w_proj_c)) + (size_t)l * 1024 * 2048;
            tr_tile8(w + (size_t)k0 * 2048 + n0, 2048, ws + WS_BTBR + ((size_t)l * 6144 + br * 2048 + n0) * 1024 + k0, 1024, t); continue; }
        q -= J_WBR;
        if (q < J_WOUT) { const int l = q >> 8, rem = q & 255, nt = rem >> 4, kt = rem & 15, n0 = nt * 128, k0 = kt * 128;
            tr_tile8(p.w_out + ((size_t)l * 2048 + k0) * 2048 + n0, 2048, ws + WS_BTOUT + ((size_t)l * 2048 + n0) * 2048 + k0, 2048, t); continue; }
        q -= J_WOUT;
        { const int bl = q >> 4, rem = q & 15, nt = rem >> 1, kt = rem & 1, n0 = nt * 128, k0 = kt * 128;
            tr_tile<128>(p.cache_v + ((size_t)bl * 256 + k0) * 1024 + n0, 1024, cvt + ((size_t)bl * 1024 + n0) * 256 + k0, 256, t); }
    }
    { float* sm = (float*)(ws + WS_SM); const size_t g0 = (size_t)blockIdx.x * 512 + tid, gs = (size_t)gridDim.x * 512;
#define CPY(off, src, n) for (size_t i = g0; i < (size_t)(n); i += gs) sm[(off) + i] = (src)[i]
      CPY(SM_RPB, p.rpb, 7440); CPY(SM_WG, p.gla_w_gate, 32768); CPY(SM_BGT, p.gla_b_gate, 2048); CPY(SM_NG, p.gla_norm_g, 2048); CPY(SM_CW, p.conv_w, 63488); CPY(SM_CB, p.conv_b, 2048);
      CPY(SM_CNG, p.conv_norm_g, 2048); CPY(SM_CNB, p.conv_norm_b, 2048); CPY(SM_LNG, p.ln_g, 4096); CPY(SM_LNB, p.ln_b, 4096); CPY(SM_ST, p.state_gla, 1048576);
#undef CPY
    }
    bf16_t* ck = (bf16_t*)(ws + WS_CK);
    for (size_t i = (size_t)blockIdx.x * 512 + tid; i < 131072; i += (size_t)gridDim.x * 512) {
        const float4 a = *(const float4*)(p.cache_k + i * 8), b = *(const float4*)(p.cache_k + i * 8 + 4);
        u32x4 w; w.x = cvt_pk_bf16(a.x, a.y); w.y = cvt_pk_bf16(a.z, a.w); w.z = cvt_pk_bf16(b.x, b.y); w.w = cvt_pk_bf16(b.z, b.w);
        *(u32x4*)(ck + i * 8) = w; }
}
__device__ __forceinline__ void phase0b(const Params p) {
    const float* modp = (const float*)(ows(p) + WS_P); float* mod = (float*)(ows(p) + WS_MOD);
    for (int idx = blockIdx.x * 512 + otid(); idx < 36864; idx += gridDim.x * 512) {
        const int l = idx / 18432, rem = idx % 18432, v = rem / 6144, n = rem % 6144;
        float s = p.b_mod[l * 6144 + n];
#pragma unroll 8
        for (int sl = 0; sl < 128; ++sl) s += modp[((size_t)(l * 128 + sl) * 3 + v) * 6144 + n];
        mod[idx] = s; }
}

template <int MODE> __device__ __forceinline__ void ln_phase(const Params p, int l) {
    const int tid = otid(), wid = tid >> 6, lane = tid & 63;
    const float* Z = (const float*)(ows(p) + WS_P); float* X1 = (float*)(ows(p) + WS_X1); bf16_t* H = (bf16_t*)(ows(p) + WS_H); const float* mod = (const float*)(ows(p) + WS_MOD);
    for (int row = blockIdx.x * 8 + wid; row < T_ALL; row += gridDim.x * 8) {
        const float* src = (MODE == 0) ? (row < T_CTX ? p.x_prompt + (size_t)row * DM : p.x_sample + (size_t)(row - T_CTX) * DM) : Z + (size_t)row * DM;
        float4 v[8]; float s = 0.f;
#pragma unroll
        for (int j = 0; j < 8; ++j) { v[j] = *(const float4*)(src + j * 256 + lane * 4); s += (v[j].x + v[j].y) + (v[j].z + v[j].w); }
        float mean = wsum(s) * (1.0f / 2048.0f), q = 0.f;
#pragma unroll
        for (int j = 0; j < 8; ++j) { const float a = v[j].x - mean, b = v[j].y - mean, c = v[j].z - mean, d = v[j].w - mean; q += (a * a + b * b) + (c * c + d * d); }
        float rstd = rsqrtf(wsum(q) * (1.0f / 2048.0f) + 1e-5f);
        if (MODE >= 1) {
            const float* g = (const float*)(ows(p) + WS_SM) + SM_LNG + (size_t)(l - 1) * DM; const float* bb = (const float*)(ows(p) + WS_SM) + SM_LNB + (size_t)(l - 1) * DM;
            float* dst = (MODE == 2) ? p.out + OUT_Y + (size_t)row * DM : X1 + (size_t)row * DM; s = 0.f;
#pragma unroll
            for (int j = 0; j < 8; ++j) { const float4 gg = *(const float4*)(g + j * 256 + lane * 4), b4 = *(const float4*)(bb + j * 256 + lane * 4);
                v[j].x = (v[j].x - mean) * rstd * gg.x + b4.x; v[j].y = (v[j].y - mean) * rstd * gg.y + b4.y; v[j].z = (v[j].z - mean) * rstd * gg.z + b4.z; v[j].w = (v[j].w - mean) * rstd * gg.w + b4.w;
                if (MODE == 2) *(float4*)(dst + j * 256 + lane * 4) = v[j];
                else { u32x2 xw; xw.x = cvt_pk_bf16(v[j].x, v[j].y); xw.y = cvt_pk_bf16(v[j].z, v[j].w); *(u32x2*)((bf16_t*)X1 + (size_t)row * DM + j * 256 + lane * 4) = xw; }
                s += (v[j].x + v[j].y) + (v[j].z + v[j].w); }
            if (MODE == 2) continue;
            mean = wsum(s) * (1.0f / 2048.0f); q = 0.f;
#pragma unroll
            for (int j = 0; j < 8; ++j) { const float a = v[j].x - mean, b = v[j].y - mean, c = v[j].z - mean, d = v[j].w - mean; q += (a * a + b * b) + (c * c + d * d); }
            rstd = rsqrtf(wsum(q) * (1.0f / 2048.0f) + 1e-5f);
        }
        const int vv = row < T_CTX ? 0 : 1 + ((row - T_CTX) >> 11);
        const float* md = mod + (size_t)(l * 3 + vv) * 6144;
#pragma unroll
        for (int j = 0; j < 8; ++j) { const float4 sh = *(const float4*)(md + j * 256 + lane * 4), sc = *(const float4*)(md + 2048 + j * 256 + lane * 4);
            u32x2 w; w.x = cvt_pk_bf16((v[j].x - mean) * rstd * (1.0f + sc.x) + sh.x, (v[j].y - mean) * rstd * (1.0f + sc.y) + sh.y);
            w.y = cvt_pk_bf16((v[j].z - mean) * rstd * (1.0f + sc.z) + sh.z, (v[j].w - mean) * rstd * (1.0f + sc.w) + sh.w);
            *(u32x2*)(H + (size_t)row * DM + j * 256 + lane * 4) = w;
            *(unsigned*)(ows(p) + WS_H8 + (size_t)row * DM + j * 256 + lane * 4) = pk4_fp8(bflo(w.x), bfhi(w.x), bflo(w.y), bfhi(w.y)); }
    }
}

__device__ __forceinline__ void lr_phase(const Params p, int l) {
    const int tid = otid(), wid = tid >> 6, lane = tid & 63, r = lane & 15, qd = lane >> 4;
    const bf16_t* H = (const bf16_t*)(ows(p) + WS_H); const bf16_t* bt = (const bf16_t*)(ows(p) + WS_BTIN) + ((size_t)l * RB + 3584) * 2048; float* LR = (float*)(ows(p) + WS_LR);
    for (int it = blockIdx.x * 8 + wid; it < T_ALL / 16; it += gridDim.x * 8) {
        const bf16_t* ap = H + (size_t)(it * 16 + r) * DM + qd * 8; const bf16_t* b0 = bt + (size_t)r * 2048 + qd * 8; const bf16_t* b1 = b0 + 16 * 2048;
        f32x4 c0 = {0.f, 0.f, 0.f, 0.f}, c1 = {0.f, 0.f, 0.f, 0.f};
#pragma unroll 8
        for (int ks = 0; ks < 64; ++ks) { const bf16x8 a = *(const bf16x8*)(ap + ks * 32); c0 = mfma16(a, *(const bf16x8*)(b0 + ks * 32), c0); c1 = mfma16(a, *(const bf16x8*)(b1 + ks * 32), c1); }
#pragma unroll
        for (int jj = 0; jj < 4; ++jj) { float* o = LR + (size_t)(it * 16 + qd * 4 + jj) * 32; o[r] = c0[jj]; o[16 + r] = c1[jj]; }
    }
}

template <bool F8> struct EpiInT {
    static constexpr bool PERM = true, AFTER_DRAIN = false, FP8 = F8;
    bf16_t* P; float* newk; int l;
    __device__ __forceinline__ void operator()(const f32x4 (&acc)[2][2][4][2], const Unit& u, int wr, int wc, int fr, int fq) const {
        const int j = u.pn;
        const int jb = F8 ? j - 50 : j;
        const int ptb = (jb < 4 ? 4 + jb : (jb < 6 ? 14 + (jb - 4) : 16 + (jb - 6)));
        const int pt = (F8 && j < 50) ? (j < 4 ? j : (j < 8 ? 8 + (j - 4) : (j < 10 ? 12 + (j - 8) : 20 + (j - 10)))) : ptb;
        const int row0 = u.pm * 256 + wr * 64 + fr, col0 = pt * 256 + wc * 32 + 8 * fq; const bool isk = !F8 && (j < 4) && (u.pm < 32);
        const float sc = F8 ? (1.0f / 64.0f) : 1.0f;
#pragma unroll
        for (int ai = 0; ai < 2; ++ai)
#pragma unroll
            for (int m = 0; m < 4; ++m) { const int r = row0 + ai * 128 + m * 16;
#pragma unroll
                for (int bj = 0; bj < 2; ++bj) { const int c = col0 + bj * 128; const f32x4 v0 = acc[ai][bj][m][0] * sc, v1 = acc[ai][bj][m][1] * sc;
                    u32x4 w; w.x = cvt_pk_bf16(v0[0], v0[1]); w.y = cvt_pk_bf16(v0[2], v0[3]); w.z = cvt_pk_bf16(v1[0], v1[1]); w.w = cvt_pk_bf16(v1[2], v1[3]);
                    *(u32x4*)(P + (size_t)r * NP + c) = w;
                    if (isk) { float* d = newk + ((size_t)((r >> 8) * 2 + l) * 256 + (r & 255)) * 1024 + (c - 1024); *(f32x4*)d = v0; *(f32x4*)(d + 4) = v1; } } }
    }
};
struct In8Order {
    StaticOrder so; int G, c;
    __device__ bool next(int i, Unit& u) const { const int L = i * G + c; if (L < 2400) return so.next(i, u); const int L2 = L - 2400; if (L2 >= 160) return false; u.pm = 32 + L2 / 10; u.pn = 50 + L2 % 10; return true; }
    __device__ __forceinline__ void a_ready(const Unit&) const {}
    __device__ __forceinline__ void done(const Unit&) const {}
};
struct EpiV {
    static constexpr bool PERM = true, AFTER_DRAIN = false, FP8 = false;
    bf16_t* VT; float* newv; int l;
    __device__ __forceinline__ void operator()(const f32x4 (&acc)[2][2][4][2], const Unit& u, int wr, int wc, int fr, int fq) const {
        const int row0 = u.pm * 256 + wr * 64 + fr, col0 = u.pn * 256 + wc * 32 + 8 * fq; const bool isv = u.pn < 32;
#pragma unroll
        for (int ai = 0; ai < 2; ++ai)
#pragma unroll
            for (int m = 0; m < 4; ++m) { const int r = row0 + ai * 128 + m * 16;
#pragma unroll
                for (int bj = 0; bj < 2; ++bj) { const int c = col0 + bj * 128; const f32x4 v0 = acc[ai][bj][m][0], v1 = acc[ai][bj][m][1];
                    u32x4 w; w.x = cvt_pk_bf16(v0[0], v0[1]); w.y = cvt_pk_bf16(v0[2], v0[3]); w.z = cvt_pk_bf16(v1[0], v1[1]); w.w = cvt_pk_bf16(v1[2], v1[3]);
                    *(u32x4*)(VT + (size_t)r * T_ALL + c) = w;
                    if (isv) { float* d = newv + ((size_t)((c >> 8) * 2 + l) * 256 + (c & 255)) * 1024 + r;
#pragma unroll
                        for (int j = 0; j < 4; ++j) { d[(size_t)j * 1024] = v0[j]; d[(size_t)(j + 4) * 1024] = v1[j]; } } } }
    }
};
struct BrOrder {
    StaticOrder so;
    __device__ bool next(int i, Unit& u) const { Unit t; if (!so.next(i, t)) return false; u.pm = t.pm; u.pn = (t.pm / 48) * 8 + t.pn; return true; }
    __device__ __forceinline__ void a_ready(const Unit&) const {}
    __device__ __forceinline__ void done(const Unit&) const {}
};
struct EpiBr {
    static constexpr bool PERM = true, AFTER_DRAIN = false, FP8 = true;
    bf16_t* B01; bf16_t* B2;
    __device__ __forceinline__ void operator()(const f32x4 (&acc)[2][2][4][2], const Unit& u, int wr, int wc, int fr, int fq) const {
        const int br = u.pm / 48, pm = u.pm - br * 48, pn = u.pn - br * 8;
        const int row0 = pm * 256 + wr * 64 + fr, col0 = pn * 256 + wc * 32 + 8 * fq; unsigned char* O = (br == 2) ? (unsigned char*)B2 : (unsigned char*)B01 + (size_t)br * T_ALL * DM;
#pragma unroll
        for (int ai = 0; ai < 2; ++ai)
#pragma unroll
            for (int m = 0; m < 4; ++m) { const int r = row0 + ai * 128 + m * 16;
#pragma unroll
                for (int bj = 0; bj < 2; ++bj) { const int c = col0 + bj * 128; const f32x4 v0 = acc[ai][bj][m][0] * 0.25f, v1 = acc[ai][bj][m][1] * 0.25f;
                    u32x2 w; w.x = pk4_fp8(v0[0], v0[1], v0[2], v0[3]); w.y = pk4_fp8(v1[0], v1[1], v1[2], v1[3]);
                    *(u32x2*)(O + (size_t)r * DM + c) = w; } }
    }
};
__device__ __forceinline__ void merge_phase(const Params p) {
    const int tid = otid(), wid = tid >> 6, lane = tid & 63;
    const bf16_t* P = (const bf16_t*)(ows(p) + WS_P); const bf16_t* B01 = (const bf16_t*)(ows(p) + WS_OG); const bf16_t* B2 = (const bf16_t*)(ows(p) + WS_H); bf16_t* MRG = (bf16_t*)(ows(p) + WS_MRG);
    for (int row = blockIdx.x * 8 + wid; row < T_ALL; row += gridDim.x * 8) {
#pragma unroll
        for (int j = 0; j < 4; ++j) { const int c = j * 512 + lane * 8; float a[8];
#pragma unroll
            for (int i = 0; i < 8; ++i) a[i] = 0.f;
#pragma unroll
            for (int br = 0; br < 3; ++br) { const unsigned char* bp = (br == 2 ? (const unsigned char*)B2 : (const unsigned char*)B01 + (size_t)br * T_ALL * DM) + (size_t)row * DM + c;
                const u32x2 x = *(const u32x2*)bp; const u32x4 g = *(const u32x4*)(P + (size_t)row * NP + (br == 0 ? PGA : (br == 1 ? PGB : PGC)) + c);
                typedef float f32x2m __attribute__((ext_vector_type(2)));
                const f32x2m x01 = __builtin_amdgcn_cvt_pk_f32_fp8((int)x.x, false), x23 = __builtin_amdgcn_cvt_pk_f32_fp8((int)x.x, true), x45 = __builtin_amdgcn_cvt_pk_f32_fp8((int)x.y, false), x67 = __builtin_amdgcn_cvt_pk_f32_fp8((int)x.y, true);
                a[0] += x01.x * sigmoidf_(bflo(g.x)); a[1] += x01.y * sigmoidf_(bfhi(g.x)); a[2] += x23.x * sigmoidf_(bflo(g.y)); a[3] += x23.y * sigmoidf_(bfhi(g.y));
                a[4] += x45.x * sigmoidf_(bflo(g.z)); a[5] += x45.y * sigmoidf_(bfhi(g.z)); a[6] += x67.x * sigmoidf_(bflo(g.w)); a[7] += x67.y * sigmoidf_(bfhi(g.w)); }
            u32x2 w; w.x = pk4_fp8(a[0] * 0.0625f, a[1] * 0.0625f, a[2] * 0.0625f, a[3] * 0.0625f); w.y = pk4_fp8(a[4] * 0.0625f, a[5] * 0.0625f, a[6] * 0.0625f, a[7] * 0.0625f);
            *(u32x2*)((unsigned char*)MRG + (size_t)row * DM + c) = w; } }
}
struct EpiOut {
    static constexpr bool PERM = false, AFTER_DRAIN = false, FP8 = true;
    const float *xp, *xs, *x1; const float* mod; float* Z; int l;
    __device__ __forceinline__ void operator()(const f32x4 (&acc)[2][2][4][2], const Unit& u, int wr, int wc, int fr, int fq) const {
        const int row0 = u.pm * 256 + wr * 64 + fr, col0 = u.pn * 256 + wc * 32 + 4 * fq;
#pragma unroll
        for (int ai = 0; ai < 2; ++ai)
#pragma unroll
            for (int m = 0; m < 4; ++m) { const int r = row0 + ai * 128 + m * 16;
                const float* x = (l == 0) ? (r < T_CTX ? xp + (size_t)r * DM : xs + (size_t)(r - T_CTX) * DM) : x1 + (size_t)r * DM;
                const int vv = r < T_CTX ? 0 : 1 + ((r - T_CTX) >> 11); const float* gt = mod + (size_t)(l * 3 + vv) * 6144 + 4096;
#pragma unroll
                for (int bj = 0; bj < 2; ++bj)
#pragma unroll
                    for (int n = 0; n < 2; ++n) { const int c = col0 + bj * 128 + n * 16; const f32x4 gv = *(const f32x4*)(gt + c); f32x4 xv;
                        if (l == 0) xv = *(const f32x4*)(x + c);
                        else { const u32x2 xb = *(const u32x2*)((const bf16_t*)x1 + (size_t)r * DM + c); xv = (f32x4){bflo(xb.x), bfhi(xb.x), bflo(xb.y), bfhi(xb.y)}; }
                        *(f32x4*)(Z + (size_t)r * DM + c) = ALPHA_DN * xv + gv * (acc[ai][bj][m][n] * (1.0f / 64.0f)); } }
    }
};

template <bool WIN> __device__ __forceinline__ void att_half(const bf16x8 (&qf)[4], const bf16_t* Kb, size_t kstride, const bf16_t* Vtb, size_t vstride, int tb0, int tbs,
                                                            f32x4 (&o)[8], float& m, float& lsum, int r, int qd, const float* rpb_h, int drbase, int qc, int bs) {
    f32x4 sc[16];
#pragma unroll
    for (int k4 = 0; k4 < 4; ++k4) {
        bf16x8 kf[4][4];
#pragma unroll
        for (int t = 0; t < 4; ++t) { const int kt = k4 * 4 + t; const int tok = tb0 + (kt >> 1) * tbs + (kt & 1) * 16 + r; const bf16_t* kp = Kb + (size_t)tok * kstride + qd * 8;
#pragma unroll
            for (int ks = 0; ks < 4; ++ks) kf[t][ks] = *(const bf16x8*)(kp + ks * 32); }
        asm volatile("" : "+v"(kf[0][0]), "+v"(kf[0][1]), "+v"(kf[0][2]), "+v"(kf[0][3]), "+v"(kf[1][0]), "+v"(kf[1][1]), "+v"(kf[1][2]), "+v"(kf[1][3]));
        asm volatile("" : "+v"(kf[2][0]), "+v"(kf[2][1]), "+v"(kf[2][2]), "+v"(kf[2][3]), "+v"(kf[3][0]), "+v"(kf[3][1]), "+v"(kf[3][2]), "+v"(kf[3][3]));
#pragma unroll
        for (int t = 0; t < 4; ++t) { f32x4 a = {0.f, 0.f, 0.f, 0.f};
#pragma unroll
            for (int ks = 0; ks < 4; ++ks) a = mfma16(kf[t][ks], qf[ks], a);
            sc[k4 * 4 + t] = a; }
        __builtin_amdgcn_sched_barrier(0);
    }
    float mx = m;
    const int cs = min(max(qc - 8, 0), 48);
#pragma unroll
    for (int kt = 0; kt < 16; ++kt)
#pragma unroll
        for (int jj = 0; jj < 4; ++jj) { float v = sc[kt][jj] * ATT_SCALE;
            if (WIN) { const int kc = bs + (kt & 1) * 16 + qd * 4 + jj; const bool valid = (kc >= cs) && (kc < cs + 16); const int dci = min(max(kc - qc + 15, 0), 30);
                const float bias = rpb_h[(drbase + (kt >> 1)) * 31 + dci]; v = valid ? v + bias : -1e30f; }
            sc[kt][jj] = v; mx = fmaxf(mx, v); }
    mx = fmaxf(mx, sxor<16>(mx)); mx = fmaxf(mx, bperm(mx, ((qd * 16 + r) ^ 32) << 2));
    const float alpha = __expf(m - mx); m = mx; lsum *= alpha;
#pragma unroll
    for (int dt = 0; dt < 8; ++dt) o[dt] *= alpha;
    unsigned pk[16][2];
#pragma unroll
    for (int kt = 0; kt < 16; ++kt) { const float p0 = __expf(sc[kt][0] - mx), p1 = __expf(sc[kt][1] - mx), p2 = __expf(sc[kt][2] - mx), p3 = __expf(sc[kt][3] - mx);
        lsum += (p0 + p1) + (p2 + p3); pk[kt][0] = cvt_pk_bf16(p0, p1); pk[kt][1] = cvt_pk_bf16(p2, p3); }
#pragma unroll
    for (int g = 0; g < 8; ++g) { u32x4 bw; bw.x = pk[2 * g][0]; bw.y = pk[2 * g][1]; bw.z = pk[2 * g + 1][0]; bw.w = pk[2 * g + 1][1];
        const bf16x8 b = __builtin_bit_cast(bf16x8, bw);
        bf16x4 lo[8], hi[8];
#pragma unroll
        for (int dt = 0; dt < 8; ++dt) { const bf16_t* vp = Vtb + (size_t)(dt * 16 + r) * vstride + tb0 + g * tbs + qd * 4; lo[dt] = *(const bf16x4*)vp; hi[dt] = *(const bf16x4*)(vp + 16); }
#pragma unroll
        for (int dt = 0; dt < 8; ++dt) o[dt] = mfma16(__builtin_shufflevector(lo[dt], hi[dt], 0, 1, 2, 3, 4, 5, 6, 7), b, o[dt]);
        if (g & 1) __builtin_amdgcn_sched_barrier(0); }
}
__device__ __forceinline__ void att_wave(const Params p, int l, bool latent, int b, int h, int tokq0, int row, int t16) {
    const int lane = otid() & 63, r = lane & 15, qd = lane >> 4;
    const bf16_t* P = (const bf16_t*)(ows(p) + WS_P); const bf16_t* VT = (const bf16_t*)(ows(p) + WS_VT); bf16_t* YA = (bf16_t*)(ows(p) + WS_YCAT);
    bf16x8 qf[4];
    { const bf16_t* qp = P + (size_t)(tokq0 + r) * NP + PQ + h * 128 + qd * 8;
#pragma unroll
        for (int ks = 0; ks < 4; ++ks) qf[ks] = *(const bf16x8*)(qp + ks * 32); }
    f32x4 o[8];
#pragma unroll
    for (int dt = 0; dt < 8; ++dt) o[dt] = (f32x4){0.f, 0.f, 0.f, 0.f};
    float m = -1e30f, lsum = 0.f;
    if (!latent) {
        att_half<false>(qf, P + (size_t)(b * 256) * NP + PK + h * 128, NP, VT + (size_t)(h * 128) * T_ALL + b * 256, T_ALL, 0, 32, o, m, lsum, r, qd, nullptr, 0, 0, 0);
    } else {
        const int rs = min(max(row - 4, 0), 24), bs = min(max(16 * t16 - 8, 0), 32), tokb = T_CTX + b * 2048;
        att_half<true>(qf, P + (size_t)tokb * NP + PK + h * 128, NP, VT + (size_t)(h * 128) * T_ALL + tokb, T_ALL, rs * 64 + bs, 64, o, m, lsum, r, qd,
                       (const float*)(ows(p) + WS_SM) + SM_RPB + (size_t)(l * 8 + h) * 15 * 31, rs - row + 7, t16 * 16 + r, bs);
        att_half<false>(qf, (const bf16_t*)(ows(p) + WS_CK) + (size_t)((b * 2 + l) * 256) * 1024 + h * 128, 1024,
                        (const bf16_t*)(ows(p) + WS_CVT) + (size_t)((b * 2 + l) * 1024 + h * 128) * 256, 256, 0, 32, o, m, lsum, r, qd, nullptr, 0, 0, 0);
    }
    lsum += sxor<16>(lsum); lsum += bperm(lsum, (lane ^ 32) << 2);
#if defined(PROBE_ZERO_LAT)
    const float inv = latent ? 0.f : 1.0f / lsum;
#elif defined(PROBE_ZERO_CTX)
    const float inv = latent ? 1.0f / lsum : 0.f;
#else
    const float inv = 1.0f / lsum;
#endif
    const size_t tok = (size_t)(tokq0 + r);
#pragma unroll
    for (int dt = 0; dt < 8; ++dt) { const int dim = h * 128 + dt * 16 + qd * 4; const u32x2 z = *(const u32x2*)(P + tok * NP + PZA + dim);
        *(unsigned*)((unsigned char*)YA + tok * 1024 + dim) = pk4_fp8(o[dt][0] * inv * siluf_(bflo(z.x)), o[dt][1] * inv * siluf_(bfhi(z.x)), o[dt][2] * inv * siluf_(bflo(z.y)), o[dt][3] * inv * siluf_(bfhi(z.y))); }
}

constexpr int G_QE = 0, G_KE = 17408, G_KLT = 34816, G_BL = 53248, G_VT = 53760, G_ATT = 90624, G_WG = 99840, G_BG = 108032;
constexpr int G_IMG = 53760;
__device__ __forceinline__ size_t gla_unit(bool latent, int b, int h, int dir, int c) { return latent ? (size_t)(1024 + ((b * 4 + h) * 2 + dir) * 32 + c) : (size_t)(((b * 4 + h) * 2 + dir) * 4 + c); }
__device__ __forceinline__ void gla_stage(const Params p, int l, bool latent, int b, int h, int dir, int c0, LAS unsigned char* lds) {
    const int tid = otid(), w = tid >> 6, lane = tid & 63;
    const int L = latent ? 2048 : 256, tok0 = latent ? T_CTX + b * 2048 : b * 256;
    const bf16_t* P = (const bf16_t*)(ows(p) + WS_P); const float* LR = (const float*)(ows(p) + WS_LR);
    LAS bf16_t* QE = (LAS bf16_t*)(lds + G_QE); LAS bf16_t* KE = (LAS bf16_t*)(lds + G_KE); LAS bf16_t* KLT = (LAS bf16_t*)(lds + G_KLT);
    LAS float* WG = (LAS float*)(lds + G_WG); LAS float* BG = (LAS float*)(lds + G_BG); LAS float* BL = (LAS float*)(lds + G_BL);
    for (int i = tid; i < 2048; i += 512) WG[i] = ((const float*)(ows(p) + WS_SM) + SM_WG)[((size_t)(l * 2 + dir) * 16 + (i >> 7)) * 512 + h * 128 + (i & 127)];
    if (tid < 128) BG[tid] = ((const float*)(ows(p) + WS_SM) + SM_BGT)[(size_t)(l * 2 + dir) * 512 + h * 128 + tid];
    __syncthreads();
    const int d0 = w * 16;
    for (int c = c0; c < c0 + 4; ++c) {
        { const int pos = c * 64 + lane; const int tl = dir ? (L - 1 - pos) : pos; const size_t tok = (size_t)(tok0 + tl); const bf16_t* prow = P + tok * NP;
            float lr[16];
            { const float4* lp = (const float4*)(LR + tok * 32 + dir * 16);
#pragma unroll
              for (int i = 0; i < 4; ++i) { const float4 t4 = lp[i]; lr[4 * i] = t4.x; lr[4 * i + 1] = t4.y; lr[4 * i + 2] = t4.z; lr[4 * i + 3] = t4.w; } }
#pragma unroll
            for (int hf = 0; hf < 4; ++hf) { const int dd = d0 + hf * 4;
                float qv[4], kv[4];
                { const u32x2 a0 = *(const u32x2*)(prow + PBQ + h * 128 + dd), b0 = *(const u32x2*)(prow + PBK + h * 128 + dd);
                  qv[0] = bflo(a0.x); qv[1] = bfhi(a0.x); qv[2] = bflo(a0.y); qv[3] = bfhi(a0.y); kv[0] = bflo(b0.x); kv[1] = bfhi(b0.x); kv[2] = bflo(b0.y); kv[3] = bfhi(b0.y); }
                if (latent) {
                    const int dp = dd ^ 32; float qp[4], kp2[4];
                    { const u32x2 a0 = *(const u32x2*)(prow + PBQ + h * 128 + dp), b0 = *(const u32x2*)(prow + PBK + h * 128 + dp);
                      qp[0] = bflo(a0.x); qp[1] = bfhi(a0.x); qp[2] = bflo(a0.y); qp[3] = bfhi(a0.y); kp2[0] = bflo(b0.x); kp2[1] = bfhi(b0.x); kp2[2] = bflo(b0.y); kp2[3] = bfhi(b0.y); }
                    const float posf = (float)((dd < 64) ? (tl >> 6) : (tl & 63)); const bool second = (dd & 32) != 0; const int f0 = dd & 31;
#pragma unroll
                    for (int i = 0; i < 4; ++i) { const float inv = __expf(-(float)(2 * (f0 + i)) * (9.210340371976184f / 64.0f)); const float ang = posf * inv; float sn, cn; __sincosf(ang, &sn, &cn);
                        const float q1 = second ? qp[i] : qv[i], q2 = second ? qv[i] : qp[i], k1 = second ? kp2[i] : kv[i], k2 = second ? kv[i] : kp2[i];
                        qv[i] = second ? (q1 * sn + q2 * cn) : (q1 * cn - q2 * sn); kv[i] = second ? (k1 * sn + k2 * cn) : (k1 * cn - k2 * sn); }
                }
                unsigned qe[2], ke[2];
#pragma unroll
                for (int i = 0; i < 4; ++i) { float g = BG[dd + i];
#pragma unroll
                    for (int rr = 0; rr < 16; ++rr) g += lr[rr] * WG[rr * 128 + dd + i];
                    float la = -(fmaxf(-g, 0.f) + __logf(1.0f + __expf(-fabsf(g)))) * (1.0f / 16.0f);
#pragma unroll
                    for (int off = 1; off < 64; off <<= 1) { const float t_ = bperm(la, ((lane - off) & 63) << 2); if (lane >= off) la += t_; }
                    const float bl = rlane(la, 63);
                    const float eb = __expf(la), enb = __expf(-la), elb = __expf(bl - la);
                    const float qq = qv[i] * ATT_SCALE * eb, kk = kv[i] * enb, kl = kv[i] * elb;
                    if (i & 1) { qe[i >> 1] = cvt_pk_bf16(__uint_as_float(qe[i >> 1]), qq); ke[i >> 1] = cvt_pk_bf16(__uint_as_float(ke[i >> 1]), kk); }
                    else { qe[i >> 1] = __float_as_uint(qq); ke[i >> 1] = __float_as_uint(kk); }
                    if (lane == 63) BL[dd + i] = __expf(bl);
                    KLT[(dd + i) * 72 + lane] = f2bf(kl); }
                { u32x2 w0; w0.x = qe[0]; w0.y = qe[1]; *(LAS u32x2*)(QE + lane * 136 + dd) = w0; w0.x = ke[0]; w0.y = ke[1]; *(LAS u32x2*)(KE + lane * 136 + dd) = w0; }
            }
        }
        __syncthreads();
        { u32x4* dst = (u32x4*)(ows(p) + WS_GST + gla_unit(latent, b, h, dir, c) * G_IMG);
          for (int i = tid; i < G_IMG / 16; i += 512) dst[i] = *(const LAS u32x4*)(lds + i * 16); }
        __syncthreads();
    }
}
#define LDS_BARRIER() do { asm volatile("s_waitcnt lgkmcnt(0)" ::: "memory"); __builtin_amdgcn_s_barrier(); asm volatile("" ::: "memory"); } while (0)
template <int NS> __device__ __forceinline__ void gla_item(const Params p, int l, bool latent, int b, int h, int dir, int sl, LAS unsigned char* lds) {
    constexpr int X = 2 / NS, NV = 4 / NS; constexpr bool PFE = (NS == 2);
    const int tid = otid(), w = tid >> 6, lane = tid & 63, r = lane & 15, qd = lane >> 4;
    const int L = latent ? 2048 : 256, nch = L >> 6, tok0 = latent ? T_CTX + b * 2048 : b * 256;
    const bf16_t* P = (const bf16_t*)(ows(p) + WS_P); float* OG = (float*)(ows(p) + WS_OG) + (size_t)dir * T_ALL * 1024;
    LAS bf16_t* QE = (LAS bf16_t*)(lds + G_QE); LAS bf16_t* KE = (LAS bf16_t*)(lds + G_KE); LAS bf16_t* KLT = (LAS bf16_t*)(lds + G_KLT); LAS bf16_t* VTs = (LAS bf16_t*)(lds + G_VT);
    LAS bf16_t* ATT = (LAS bf16_t*)(lds + G_ATT); LAS float* BL = (LAS float*)(lds + G_BL);
    const int et0 = (NS == 1) ? 2 * w : sl * 8 + w;
    const int eb = (NS == 1) ? w * 32 : sl * 128 + w * 16;
    f32x4 S[X][8];
    const size_t sidx = ((((size_t)(b * 2 + l) * 2 + dir) * 4 + h) * 128 + qd * 4) * 256 + et0 * 16 + r;
#pragma unroll
    for (int x = 0; x < X; ++x)
#pragma unroll
        for (int dt = 0; dt < 8; ++dt)
#pragma unroll
            for (int jj = 0; jj < 4; ++jj) S[x][dt][jj] = latent ? ((const float*)(ows(p) + WS_SM) + SM_ST)[sidx + (size_t)(dt * 16 + jj) * 256 + x * 16] : 0.f;
    u32x4 pf[7], vpf[NV];
#define GLA_PF_LOAD(cc) do { const u32x4* srcp_ = (const u32x4*)(ows(p) + WS_GST + gla_unit(latent, b, h, dir, (cc)) * G_IMG); \
        _Pragma("unroll") for (int k_ = 0; k_ < 7; ++k_) { const int i_ = tid + k_ * 512; if (i_ < G_IMG / 16) pf[k_] = srcp_[i_]; } \
        const int pos_ = (cc) * 64 + lane; const int tl_ = dir ? (L - 1 - pos_) : pos_; const bf16_t* prow_ = P + (size_t)(tok0 + tl_) * NP + PBV + h * 256 + eb; \
        _Pragma("unroll") for (int k4_ = 0; k4_ < NV; ++k4_) vpf[k4_] = *(const u32x4*)(prow_ + k4_ * 8); } while (0)
#define GLA_PF_STORE() do { \
        _Pragma("unroll") for (int k_ = 0; k_ < 7; ++k_) { const int i_ = tid + k_ * 512; if (i_ < G_IMG / 16) *(LAS u32x4*)(lds + i_ * 16) = pf[k_]; } \
        _Pragma("unroll") for (int k4_ = 0; k4_ < NV; ++k4_) { const unsigned vw_[4] = {vpf[k4_].x, vpf[k4_].y, vpf[k4_].z, vpf[k4_].w}; \
            _Pragma("unroll") for (int i_ = 0; i_ < 4; ++i_) { VTs[(eb + k4_ * 8 + 2 * i_) * 72 + lane] = (bf16_t)(vw_[i_] & 0xffffu); VTs[(eb + k4_ * 8 + 2 * i_ + 1) * 72 + lane] = (bf16_t)(vw_[i_] >> 16); } } } while (0)
    if (PFE) GLA_PF_LOAD(0);
    for (int c = 0; c < nch; ++c) {
        if (!PFE) GLA_PF_LOAD(c);
        GLA_PF_STORE();
        LDS_BARRIER();
        if (PFE && c + 1 < nch) GLA_PF_LOAD(c + 1);
#pragma unroll
        for (int x = 0; x < 2; ++x) { const int id = 2 * w + x, it = id >> 2, jt = id & 3; f32x4 a = {0.f, 0.f, 0.f, 0.f};
#pragma unroll
            for (int ks = 0; ks < 4; ++ks) a = mfma16(*(const LAS bf16x8*)(QE + (it * 16 + r) * 136 + ks * 32 + qd * 8), *(const LAS bf16x8*)(KE + (jt * 16 + r) * 136 + ks * 32 + qd * 8), a);
#pragma unroll
            for (int jj = 0; jj < 4; ++jj) { const int i = it * 16 + qd * 4 + jj, j = jt * 16 + r; ATT[i * 72 + j] = f2bf((dir ? i > j : i >= j) ? a[jj] : 0.f); } }
        LDS_BARRIER();
#pragma unroll
        for (int x = 0; x < X; ++x) { const int et = et0 + x;
            bf16x8 sb[4];
#pragma unroll
            for (int dp = 0; dp < 4; ++dp) { u32x4 t; t.x = cvt_pk_bf16(S[x][2 * dp][0], S[x][2 * dp][1]); t.y = cvt_pk_bf16(S[x][2 * dp][2], S[x][2 * dp][3]);
                t.z = cvt_pk_bf16(S[x][2 * dp + 1][0], S[x][2 * dp + 1][1]); t.w = cvt_pk_bf16(S[x][2 * dp + 1][2], S[x][2 * dp + 1][3]); sb[dp] = __builtin_bit_cast(bf16x8, t); }
            const bf16x8 v0 = *(const LAS bf16x8*)(VTs + (et * 16 + r) * 72 + qd * 8), v1 = *(const LAS bf16x8*)(VTs + (et * 16 + r) * 72 + 32 + qd * 8);
#pragma unroll 1
            for (int it = 0; it < 4; ++it) { f32x4 a = {0.f, 0.f, 0.f, 0.f};
                a = mfma16(*(const LAS bf16x8*)(ATT + (it * 16 + r) * 72 + qd * 8), v0, a); a = mfma16(*(const LAS bf16x8*)(ATT + (it * 16 + r) * 72 + 32 + qd * 8), v1, a);
#pragma unroll
                for (int dp = 0; dp < 4; ++dp) { const LAS bf16_t* qp_ = QE + (it * 16 + r) * 136 + dp * 32 + qd * 4;
                    const bf16x4 lo = *(const LAS bf16x4*)qp_, hi = *(const LAS bf16x4*)(qp_ + 16);
                    a = mfma16(__builtin_shufflevector(lo, hi, 0, 1, 2, 3, 4, 5, 6, 7), sb[dp], a); }
#pragma unroll
                for (int jj = 0; jj < 4; ++jj) { const int pos = c * 64 + it * 16 + qd * 4 + jj; const int tl = dir ? (L - 1 - pos) : pos;
                    OG[(size_t)(tok0 + tl) * 1024 + h * 256 + et * 16 + r] = a[jj]; } }
#pragma unroll
            for (int dt = 0; dt < 8; ++dt) { const f32x4 dec = *(const LAS f32x4*)(BL + dt * 16 + qd * 4); f32x4 s = S[x][dt] * dec;
                s = mfma16(*(const LAS bf16x8*)(KLT + (dt * 16 + r) * 72 + qd * 8), v0, s); s = mfma16(*(const LAS bf16x8*)(KLT + (dt * 16 + r) * 72 + 32 + qd * 8), v1, s);
                S[x][dt] = s; if (dt & 1) __builtin_amdgcn_sched_barrier(0); } }
        LDS_BARRIER();
    }
#undef GLA_PF_LOAD
#undef GLA_PF_STORE
    if (!latent) { float* so = p.out + OUT_S;
#pragma unroll
        for (int x = 0; x < X; ++x)
#pragma unroll
            for (int dt = 0; dt < 8; ++dt)
#pragma unroll
                for (int jj = 0; jj < 4; ++jj) so[sidx + (size_t)(dt * 16 + jj) * 256 + x * 16] = S[x][dt][jj]; }
}

__device__ __forceinline__ void conv_item(const Params p, int l, int item, LAS unsigned char* lds) {
    const int tid = otid(), wid = tid >> 6, lane = tid & 63; const int R0 = item * 16;
    const int s0 = R0 < T_CTX ? (R0 & ~255) : T_CTX + ((R0 - T_CTX) & ~2047), s1 = s0 + (R0 < T_CTX ? 256 : 2048);
    const bf16_t* P = (const bf16_t*)(ows(p) + WS_P); unsigned char* YC = ows(p) + WS_YCAT + 2ull * T_ALL * 1024;
    LAS bf16_t* U = (LAS bf16_t*)lds;
    LAS float* RED = (LAS float*)(lds + 94208);
    LAS float* STAT = (LAS float*)(lds + 94208 + 1024);
#pragma unroll
    for (int kb = 0; kb < 3; ++kb) { u32x4 av[4], gv[4];
#pragma unroll
        for (int kk = 0; kk < 4; ++kk) { const int i = min(tid + (kb * 4 + kk) * 512, 46 * 128 - 1); const int s = i >> 7, c8 = (i & 127) * 8; const int row = min(max(R0 - 15 + s, s0), s1 - 1);
            av[kk] = *(const u32x4*)(P + (size_t)row * NP + PCU + c8); gv[kk] = *(const u32x4*)(P + (size_t)row * NP + PCG + c8); }
#pragma unroll
        for (int kk = 0; kk < 4; ++kk) { const int i = tid + (kb * 4 + kk) * 512; const int s = i >> 7, c8 = (i & 127) * 8; const int row = R0 - 15 + s; const u32x4 a = av[kk], g = gv[kk]; u32x4 w;
            w.x = cvt_pk_bf16(bflo(a.x) * sigmoidf_(bflo(g.x)), bfhi(a.x) * sigmoidf_(bfhi(g.x))); w.y = cvt_pk_bf16(bflo(a.y) * sigmoidf_(bflo(g.y)), bfhi(a.y) * sigmoidf_(bfhi(g.y)));
            w.z = cvt_pk_bf16(bflo(a.z) * sigmoidf_(bflo(g.z)), bfhi(a.z) * sigmoidf_(bfhi(g.z))); w.w = cvt_pk_bf16(bflo(a.w) * sigmoidf_(bflo(g.w)), bfhi(a.w) * sigmoidf_(bfhi(g.w)));
            if (!(row >= s0 && row < s1)) w = (u32x4){0u, 0u, 0u, 0u};
            if (i < 46 * 128) *(LAS u32x4*)(U + s * 1024 + c8) = w; } }
    const int ch = tid * 2;
    typedef float f32x2 __attribute__((ext_vector_type(2)));
    f32x2 wv2[31];
#pragma unroll
    for (int j = 0; j < 31; ++j) wv2[j] = *(const f32x2*)((const float*)(ows(p) + WS_SM) + SM_CW + ((size_t)l * 31 + j) * 1024 + ch);
    const f32x2 cb = *(const f32x2*)((const float*)(ows(p) + WS_SM) + SM_CB + (size_t)l * 1024 + ch);
    f32x2 a2[16];
#pragma unroll
    for (int t = 0; t < 16; ++t) a2[t] = cb;
    __syncthreads();
#pragma unroll
    for (int s = 0; s < 46; ++s) { const unsigned uu = *(const LAS unsigned*)(U + s * 1024 + ch); const f32x2 u2 = {bflo(uu), bfhi(uu)};
#pragma unroll
        for (int t = 0; t < 16; ++t) { const int j = s - t; if (j >= 0 && j <= 30) a2[t] = __builtin_elementwise_fma(u2, wv2[j], a2[t]); } }
    float a0[16], a1[16];
#pragma unroll
    for (int t = 0; t < 16; ++t) { a0[t] = a2[t].x; a1[t] = a2[t].y; }
#pragma unroll
    for (int t = 0; t < 16; ++t) { const float sm = wsum(a0[t] + a1[t]), sq = wsum(a0[t] * a0[t] + a1[t] * a1[t]); if (lane == 0) { RED[(wid * 16 + t) * 2] = sm; RED[(wid * 16 + t) * 2 + 1] = sq; } }
    __syncthreads();
    if (tid < 16) { float sm = 0.f, sq = 0.f;
#pragma unroll
        for (int ww = 0; ww < 8; ++ww) { sm += RED[(ww * 16 + tid) * 2]; sq += RED[(ww * 16 + tid) * 2 + 1]; }
        const float mean = sm * (1.0f / 1024.0f), var = fmaxf(sq * (1.0f / 1024.0f) - mean * mean, 0.f); STAT[tid * 2] = mean; STAT[tid * 2 + 1] = rsqrtf(var + 1e-5f); }
    __syncthreads();
    const float2 gn = *(const float2*)((const float*)(ows(p) + WS_SM) + SM_CNG + (size_t)l * 1024 + ch), bn = *(const float2*)((const float*)(ows(p) + WS_SM) + SM_CNB + (size_t)l * 1024 + ch);
#pragma unroll
    for (int t = 0; t < 16; ++t) { const float mean = STAT[t * 2], rstd = STAT[t * 2 + 1]; const size_t row = (size_t)(R0 + t);
        const unsigned zz = *(const unsigned*)(P + row * NP + PCZ + ch);
        const float y0 = (a0[t] - mean) * rstd * gn.x + bn.x, y1 = (a1[t] - mean) * rstd * gn.y + bn.y;
        *(unsigned short*)(YC + row * 1024 + ch) = (unsigned short)(__builtin_amdgcn_cvt_pk_fp8_f32(siluf_(y0) * siluf_(bflo(zz)), siluf_(y1) * siluf_(bfhi(zz)), 0, false) & 0xffff); }
}

__device__ __forceinline__ void gla_stage_phase(const Params p, int l, LAS unsigned char* lds, int ci) {
    const int tid = otid();
    int cix = ci; asm volatile("" : "+s"(cix)); unsigned* ctr = (unsigned*)(ows(p) + WS_CTL + (size_t)(CTL_Q * 4)) + cix; volatile LAS int* slot = (volatile LAS int*)(lds + LDS_CTL);
    for (;;) {
        __syncthreads();
        if (tid == 0) *slot = (int)atomicAdd(ctr, 1u);
        __syncthreads();
        const int a = *slot;
        if (a >= 128 + 256) break;
        if (a < 128) gla_stage(p, l, true, a >> 6, (a >> 4) & 3, (a >> 3) & 1, (a & 7) * 4, lds);
        else { const int q = a - 128; gla_stage(p, l, false, q >> 3, (q >> 1) & 3, q & 1, 0, lds); }
    }
}
__device__ __forceinline__ void mix_phase(const Params p, int l, LAS unsigned char* lds, int ci) {
    const int tid = otid(), w = tid >> 6;
    int cix = ci; asm volatile("" : "+s"(cix)); unsigned* ctr = (unsigned*)(ows(p) + WS_CTL + (size_t)(CTL_Q * 4)) + cix; volatile LAS int* slot = (volatile LAS int*)(lds + LDS_CTL);
    constexpr int N_GL = 32, N_AC = 512, N_NA = 256, N_GC = 512, N_CV = 768, N_ALL = N_GL + N_AC + N_NA + N_GC + N_CV;
    for (;;) {
        __syncthreads();
        if (tid == 0) *slot = (int)atomicAdd(ctr, 1u);
        __syncthreads();
        int a = *slot;
        if (a >= N_ALL) break;
#ifndef SK_GLA
        if (a < N_GL) { gla_item<2>(p, l, true, a >> 4, (a >> 2) & 3, (a >> 1) & 1, a & 1, lds);
#ifdef DBL_GLAL
            gla_item<2>(p, l, true, a >> 4, (a >> 2) & 3, (a >> 1) & 1, a & 1, lds);
#endif
            continue; }
#endif
        a -= N_GL;
#ifndef SK_ATT
        if (a < N_AC) { const int bh = a >> 1, half = a & 1, b = bh >> 3, h = bh & 7; att_wave(p, l, false, b, h, b * 256 + (half * 8 + w) * 16, 0, 0);
#ifdef DBL_ATT
            att_wave(p, l, false, b, h, b * 256 + (half * 8 + w) * 16, 0, 0);
#endif
            continue; }
        a -= N_AC;
        if (a < N_NA) { const int b = a >> 7, h = (a >> 4) & 7, row = (a & 15) * 2 + (w >> 2), t16 = w & 3; att_wave(p, l, true, b, h, T_CTX + b * 2048 + row * 64 + t16 * 16, row, t16);
#ifdef DBL_NA
            att_wave(p, l, true, b, h, T_CTX + b * 2048 + row * 64 + t16 * 16, row, t16);
#endif
            continue; }
#endif
        a -= N_NA;
#ifndef SK_GLA
        if (a < N_GC) { gla_item<2>(p, l, false, a >> 4, (a >> 2) & 3, (a >> 1) & 1, a & 1, lds);
#ifdef DBL_GLAC
            gla_item<2>(p, l, false, a >> 4, (a >> 2) & 3, (a >> 1) & 1, a & 1, lds);
#endif
            continue; }
#endif
        a -= N_GC;
#ifndef SK_CONV
        conv_item(p, l, a, lds);
#ifdef DBL_CONV
        __syncthreads();
        conv_item(p, l, a, lds);
#endif
#endif
    }
}

__device__ __forceinline__ void post_phase(const Params p, int l) {
    const int tid = otid(), wid = tid >> 6, lane = tid & 63;
    const bf16_t* P = (const bf16_t*)(ows(p) + WS_P); const float* OG = (const float*)(ows(p) + WS_OG); unsigned char* YB = ows(p) + WS_YCAT + 1ull * T_ALL * 1024;
    for (int tok = blockIdx.x * 8 + wid; tok < T_ALL; tok += gridDim.x * 8) { const bf16_t* prow = P + (size_t)tok * NP;
#pragma unroll
        for (int h = 0; h < 4; ++h) {
            const int e = h * 256 + lane * 4;
            const f32x4 of = *(const f32x4*)(OG + (size_t)tok * 1024 + e), ob = *(const f32x4*)(OG + (size_t)(T_ALL + tok) * 1024 + e);
            const u32x2 z2 = *(const u32x2*)(prow + PBZ + e);
            const f32x4 o = of + ob;
            const float rs = rsqrtf(wsum((o[0] * o[0] + o[1] * o[1]) + (o[2] * o[2] + o[3] * o[3])) * (1.0f / 256.0f) + 1e-5f);
            const f32x4 g = *(const f32x4*)((const float*)(ows(p) + WS_SM) + SM_NG + (size_t)l * 1024 + e);
            *(unsigned*)(YB + (size_t)tok * 1024 + e) = pk4_fp8(o[0] * rs * g[0] * siluf_(bflo(z2.x)), o[1] * rs * g[1] * siluf_(bfhi(z2.x)), o[2] * rs * g[2] * siluf_(bflo(z2.y)), o[3] * rs * g[3] * siluf_(bfhi(z2.y))); } }
}


#define XB_TMO      128
#define XB_XCNT(j)  (256  + 64 * (j))
#define XB_XSUB(j)  (1280 + 64 * (j))
#define XB_XGEN(j)  (2304 + 64 * (j))
#define XB_TOP      3328
#define XB_TOPGEN   3392
#define XCD_BAR_WORDS 3456
#define XB_SPIN_CAP (1u << 18)

__device__ __forceinline__ unsigned xb_ld(unsigned* p)              { return __hip_atomic_load(p, __ATOMIC_RELAXED, __HIP_MEMORY_SCOPE_AGENT); }
__device__ __forceinline__ unsigned xb_add(unsigned* p, unsigned v) { return __hip_atomic_fetch_add(p, v, __ATOMIC_RELAXED, __HIP_MEMORY_SCOPE_AGENT); }
__device__ __forceinline__ unsigned xb_xcc_id() { return (unsigned)__builtin_amdgcn_readfirstlane((int)(__builtin_amdgcn_s_getreg((3 << 11) | 20) & 0xFu)); }
#define XB_SPIN(cond, bar) do { unsigned _sp = 0; while (cond) { __builtin_amdgcn_s_sleep(1); \
    if ((++_sp & 255u) == 0u) { if (xb_ld(&(bar)[XB_TMO])) break; if (_sp > XB_SPIN_CAP) { atomicAdd(&(bar)[XB_TMO], 1u); break; } } } } while (0)

struct XcdBarrier {
    unsigned* bar; unsigned x;
    volatile LAS unsigned* st;
};

__device__ __forceinline__ XcdBarrier xcd_barrier_post(unsigned* bar, volatile LAS unsigned* st) {
    XcdBarrier b; b.bar = bar; b.x = xb_xcc_id(); b.st = st;
    if (threadIdx.x == 0) (void)xb_add(&bar[XB_XCNT(b.x)], 1u);
    return b;
}
__device__ __forceinline__ void xcd_barrier_complete(unsigned* bar, unsigned x, unsigned& nloc, unsigned& nx) {
    const unsigned G = gridDim.x * gridDim.y * gridDim.z;
    unsigned sum, cnt, mine, sp = 0u;
    for (;;) {
        sum = 0u; cnt = 0u; mine = 0u;
#pragma unroll
        for (unsigned j = 0; j < 16; ++j) { const unsigned c = xb_ld(&bar[XB_XCNT(j)]); sum += c; cnt += (c > 0u) ? 1u : 0u; mine = (j == x) ? c : mine; }
        if (sum == G) break;
        __builtin_amdgcn_s_sleep(1);
        if ((++sp & 255u) == 0u) { if (xb_ld(&bar[XB_TMO])) break; if (sp > XB_SPIN_CAP) { atomicAdd(&bar[XB_TMO], 1u); break; } }
    }
    nloc = mine > 0u ? mine : 1u; nx = cnt > 0u ? cnt : 1u;
}

__device__ __forceinline__ void xcd_barrier(const XcdBarrier& b) {
    asm volatile("s_waitcnt vmcnt(0)" ::: "memory");
    __syncthreads();
    if (threadIdx.x == 0) {
        unsigned* bar = b.bar; const unsigned bx = xb_xcc_id();
        __builtin_amdgcn_s_waitcnt(0);
        unsigned nloc = b.st[0], nx = b.st[1];
        if (nloc == 0u) { xcd_barrier_complete(bar, bx, nloc, nx); b.st[0] = nloc; b.st[1] = nx; }
        const unsigned old = xb_add(&bar[XB_XSUB(bx)], 1u);
        const unsigned gen = old / nloc;
        if (old + 1u == (gen + 1u) * nloc) {
            __builtin_amdgcn_fence(__ATOMIC_RELEASE, "agent");
            asm volatile("s_waitcnt vmcnt(0)" ::: "memory");
            const unsigned og = xb_add(&bar[XB_TOP], 1u);
            const unsigned tg = og / nx;
            if (og + 1u == (tg + 1u) * nx) xb_add(&bar[XB_TOPGEN], 1u);
            else XB_SPIN(xb_ld(&bar[XB_TOPGEN]) == tg, bar);
            __builtin_amdgcn_fence(__ATOMIC_ACQUIRE, "agent");
            xb_add(&bar[XB_XGEN(bx)], 1u);
            asm volatile("s_waitcnt vmcnt(0)" ::: "memory");
        } else {
            XB_SPIN(xb_ld(&bar[XB_XGEN(bx)]) == gen, bar);
            __builtin_amdgcn_fence(__ATOMIC_ACQUIRE, "agent");
            asm volatile("s_waitcnt vmcnt(0)" ::: "memory");
        }
    }
    __syncthreads();
}

#ifdef DBL_SYNC
#define GRID_SYNC() do { xcd_barrier(xbar); xcd_barrier(xbar); } while (0)
#else
#define GRID_SYNC() xcd_barrier(xbar)
#endif
#define ws ows(p)
template <int LL> __device__ __forceinline__ void layer_body(const Params p, LAS unsigned char* lds, const XcdBarrier& xbar, const int c) {
    constexpr int l = LL;
#ifndef SK_LN
        if (l == 0) ln_phase<0>(p, 0); else ln_phase<1>(p, 1);
#ifdef DBL_LN
        if (l == 0) ln_phase<0>(p, 0);
#endif
#endif
        GRID_SYNC();
#ifndef SK_LR
        lr_phase(p, l);
#endif
#ifndef SK_IN
        { Gemm g; g.A = (const bf16_t*)(ws + WS_H); g.Bt = (const bf16_t*)(ws + WS_BTIN) + (size_t)l * RB * 2048; g.M = T_CTX; g.N = 2560; g.K = DM;
          StaticOrder so; so.init(T_CTX, 2560, gridDim.x, c);
          EpiInT<false> e; e.P = (bf16_t*)(ws + WS_P); e.newk = p.out + OUT_K; e.l = l;
          pg8::gemm_phase<EpiInT<false>, StaticOrder>(lds, g, so, e, nullptr); }
        { Gemm g; g.A = (const bf16_t*)(ws + WS_BTIN) + ((size_t)l * RB + 2560) * 2048; g.Bt = (const bf16_t*)(ws + WS_H); g.M = 1024; g.N = T_ALL; g.K = DM;
          StaticOrder so; so.init(1024, T_ALL, gridDim.x, (c + gridDim.x - 64) % gridDim.x);
          EpiV e; e.VT = (bf16_t*)(ws + WS_VT); e.newv = p.out + OUT_V; e.l = l;
          pg8::gemm_phase<EpiV, StaticOrder>(lds, g, so, e, nullptr); }
        { Gemm g; g.A = (const bf16_t*)(ws + WS_H8); g.Bt = (const bf16_t*)(ws + WS_BT8 + (size_t)l * R8 * 2048); g.M = T_ALL; g.N = R8; g.K = DM / 2;
          In8Order so; so.so.init(T_ALL, 12800, gridDim.x, c); so.G = gridDim.x; so.c = c;
          EpiInT<true> e; e.P = (bf16_t*)(ws + WS_P); e.newk = nullptr; e.l = l;
          pg8::gemm_phase<EpiInT<true>, In8Order>(lds, g, so, e, nullptr); }
#endif
        GRID_SYNC();
#ifndef SK_MIX
        gla_stage_phase(p, l, lds, 4 + l);
        GRID_SYNC();
        mix_phase(p, l, lds, l);
#ifdef DBL_MIX
        mix_phase(p, l, lds, 2 + l);
#endif
#endif
        GRID_SYNC();
#ifndef SK_POST
        post_phase(p, l);
#ifdef DBL_POST
        post_phase(p, l);
#endif
#endif
        GRID_SYNC();
#ifndef SK_BR
#ifdef DBL_BR
        for (int rep = 0; rep < 2; ++rep)
#endif
        { Gemm g; g.A = (const bf16_t*)(ws + WS_YCAT); g.Bt = (const bf16_t*)(ws + WS_BTBR + (size_t)l * 6144 * 1024); g.M = 3 * T_ALL; g.N = 3 * DM; g.K = 512;
          BrOrder bo; bo.so.init(3 * T_ALL, DM, gridDim.x, c);
          EpiBr e; e.B01 = (bf16_t*)(ws + WS_OG); e.B2 = (bf16_t*)(ws + WS_H);
          pg8::gemm_phase<EpiBr, BrOrder>(lds, g, bo, e, nullptr); }
        GRID_SYNC();
        merge_phase(p);
#endif
        GRID_SYNC();
        { Gemm g; g.A = (const bf16_t*)(ws + WS_MRG); g.Bt = (const bf16_t*)(ws + WS_BTOUT + (size_t)l * DM * DM); g.M = T_ALL; g.N = DM; g.K = DM / 2;
#ifndef SK_OUT
#ifdef DBL_OUT
          for (int rep = 0; rep < 2; ++rep) {
#else
          {
#endif
          StaticOrder so; so.init(T_ALL, DM, gridDim.x, c);
          EpiOut e; e.xp = p.x_prompt; e.xs = p.x_sample; e.x1 = (const float*)(ws + WS_X1); e.mod = (const float*)(ws + WS_MOD); e.Z = (float*)(ws + WS_P); e.l = l;
          pg8::gemm_phase<EpiOut, StaticOrder>(lds, g, so, e, nullptr); }
#endif
        }
        GRID_SYNC();
    }
#undef ws
__global__ void __launch_bounds__(512, 2) fwd_megakernel(Params p) {
    extern __shared__ __attribute__((aligned(16))) unsigned char smem[];
    LAS unsigned char* lds = (LAS unsigned char*)smem;
    cg::grid_group grid = cg::this_grid();
    const int c = blockIdx.x;
    if (threadIdx.x < 4) ((LAS unsigned*)(lds + LDS_CTL + 16))[threadIdx.x] = 0u;
    __syncthreads();
    const XcdBarrier xbar = xcd_barrier_post((unsigned*)(ows(p) + WS_CTL), (volatile LAS unsigned*)(lds + LDS_CTL + 16));
    if (p.out == nullptr) grid.sync();
    if (threadIdx.x == 0) { const unsigned x = xb_xcc_id(); const unsigned rk = atomicAdd((unsigned*)(ows(p) + WS_CTL) + CTL_Q + 16 + x, 1u);
        ((LAS unsigned*)(lds + LDS_CTL + 32))[0] = x; ((LAS unsigned*)(lds + LDS_CTL + 32))[1] = rk; }
#ifndef SK_P0
    phase0(p, lds);
#ifdef DBL_P0
    phase0(p, lds);
#endif
#endif
    GRID_SYNC();
    phase0b(p);
    GRID_SYNC();
    int ce = c;
    { unsigned* bar = (unsigned*)(ows(p) + WS_CTL); bool ok = (gridDim.x == 256);
#pragma unroll
      for (int j = 0; j < 16; ++j) ok = ok && (xb_ld(&bar[XB_XCNT(j)]) == (j < 8 ? 32u : 0u));
      const unsigned x = ((volatile LAS unsigned*)(lds + LDS_CTL + 32))[0], rk = ((volatile LAS unsigned*)(lds + LDS_CTL + 32))[1];
      if (ok && rk < 32u && x < 8u) ce = (int)(rk * 8u + x);
      ce = __builtin_amdgcn_readfirstlane(ce); }
    layer_body<0>(p, lds, xbar, ce);
    layer_body<1>(p, lds, xbar, ce);
    ln_phase<2>(p, 2);
}
}

extern "C" void kernel_launch(void* const* d_in, const int* in_sizes, int n_in, void* d_out, int out_size, void* d_ws, size_t ws_size, hipStream_t stream) {
    static int grid_blocks = 0;
    if (!grid_blocks) {
        int dev = 0, cus = 0, per_cu = 0;
        (void)hipGetDevice(&dev);
        (void)hipDeviceGetAttribute(&cus, hipDeviceAttributeMultiprocessorCount, dev);
        (void)hipFuncSetAttribute((const void*)mk::fwd_megakernel, hipFuncAttributeMaxDynamicSharedMemorySize, mk::LDS_BYTES);
        (void)hipOccupancyMaxActiveBlocksPerMultiprocessor(&per_cu, (const void*)mk::fwd_megakernel, 512, mk::LDS_BYTES);
        if (per_cu < 1) per_cu = 1;
        grid_blocks = cus * per_cu;
        if (ws_size < mk::WS_END || n_in != 24) fprintf(stderr, "kernel_launch: workspace %zu < %zu or n_in %d != 24\n", ws_size, (size_t)mk::WS_END, n_in);
    }
    (void)hipMemsetAsync(d_ws, 0, 16384, stream);
    mk::Params p{};
    const float** pp = (const float**)&p;
    for (int i = 0; i < 24; ++i) pp[i] = (const float*)d_in[i];
    p.out = (float*)d_out; p.ws = (unsigned char*)d_ws;
    void* args[] = {&p};
    hipError_t e = hipLaunchCooperativeKernel((void*)mk::fwd_megakernel, dim3(grid_blocks), dim3(512), args, mk::LDS_BYTES, stream);
    if (e != hipSuccess) fprintf(stderr, "cooperative launch failed: %s (grid %d)\n", hipGetErrorString(e), grid_blocks);
}
```

```cpp
#include <hip/hip_runtime.h>
#include <hip/hip_cooperative_groups.h>
#include <cstdio>
namespace cg = cooperative_groups;
namespace pg8 {
#define PG8_LAS __attribute__((address_space(3)))
typedef unsigned short bf16_t;
typedef short bf16x8 __attribute__((ext_vector_type(8)));
typedef float f32x4 __attribute__((ext_vector_type(4)));
typedef unsigned u32x4 __attribute__((ext_vector_type(4)));
constexpr int BM = 256, BK = 64, HALF = 128, HTB = HALF * BK * 2  , STAGE_BYTES = 8 * HTB, NXCD = 8, WGM = 8;

__host__ __device__ __forceinline__ int lds_byte(int r, int c) { const int st = (r >> 4) * 2 + (c >> 5), rr = r & 15, cc = c & 31, ob = rr * 64 + cc * 2; return st * 1024 + (ob ^ (((ob >> 9) & 1) << 5)); }
__host__ __device__ __forceinline__ void stage_rc(int b, int& R, int& C) { const int st = b / 1024, sb = b % 1024, swz = sb ^ (((sb >> 9) & 1) << 5); R = (st >> 1) * 16 + swz / 64; C = (st & 1) * 32 + (swz % 64) / 2; }
__host__ __device__ __forceinline__ int perm32(int rho) { const int n = rho >> 4, i = rho & 15; return 8 * (i >> 2) + 4 * n + (i & 3); }

typedef short s16x16_cat __attribute__((ext_vector_type(16))); typedef int v8i_cat __attribute__((ext_vector_type(8)));
__device__ __forceinline__ v8i_cat cat16(bf16x8 a, bf16x8 b) { const s16x16_cat t = __builtin_shufflevector(a, b, 0, 1, 2, 3, 4, 5, 6, 7, 8, 9, 10, 11, 12, 13, 14, 15); return __builtin_bit_cast(v8i_cat, t); }
template <bool F8> struct Frag;
template <> struct Frag<false> { bf16x8 k[2]; };
template <> struct Frag<true> { v8i_cat v; };
struct Unit { int pm, pn; };
struct Gemm { const bf16_t* A; const bf16_t* Bt; int M, N, K; };

struct StaticOrder {
    int nM, nN, nwg, G, c;
    __host__ __device__ void init(int M, int N, int G_, int c_) { nM = M / BM; nN = N / BM; nwg = nM * nN; G = G_; c = c_; }
    __host__ __device__ bool next(int i, Unit& u) const {
        const long L = (long)i * G + c; if (L >= nwg) return false;
        int wgid = (int)L; { const int q = nwg / NXCD, r = nwg % NXCD, xcd = wgid % NXCD, off = wgid / NXCD; wgid = (xcd < r ? xcd * (q + 1) : r * (q + 1) + (xcd - r) * q) + off; }
        const int nig = WGM * nN, gid = wgid / nig, fm = gid * WGM, gsz = (nM - fm) < WGM ? (nM - fm) : WGM;
        u.pm = fm + ((wgid % nig) % gsz); u.pn = (wgid % nig) / gsz; return true;
    }
    __device__ __forceinline__ void a_ready(const Unit&) const {}
    __device__ __forceinline__ void done(const Unit&) const {}
};
typedef float f32x2_cv __attribute__((ext_vector_type(2))); typedef __bf16 bf16x2_cv __attribute__((ext_vector_type(2)));
__device__ __forceinline__ unsigned cvt_pk_bf16(float lo, float hi) { const f32x2_cv v = {lo, hi}; return __builtin_bit_cast(unsigned, __builtin_convertvector(v, bf16x2_cv)); }
template <class Epi, class Sched, bool STAMP = false>
__device__ __forceinline__ void gemm_phase(PG8_LAS unsigned char* lds, const Gemm g, const Sched& S, const Epi& E, unsigned long long* stamps) {
    int tid_ = threadIdx.x; asm volatile("" : "+v"(tid_)); const int tid = tid_, wid = __builtin_amdgcn_readfirstlane(tid >> 6), lane = tid & 63, wr = wid >> 2, wc = wid & 3, fr = lane & 15, fq = lane >> 4;
    const int K = g.K, nt = K / BK;
    int ts_lo = 0, ts_hi = 0, nts = 0; const unsigned long long rt_entry = STAMP ? (unsigned long long)wall_clock64() : 0ull;
#define PG8_STAMP() do { if (STAMP && wid == 0 && nts < 64) { const unsigned long long _c = (unsigned long long)clock64(); \
        ts_lo = (lane == nts) ? (int)(unsigned)_c : ts_lo; ts_hi = (lane == nts) ? (int)(unsigned)(_c >> 32) : ts_hi; ++nts; } } while (0)
    PG8_STAMP();
    unsigned voffA[2], voffB[2];
#pragma unroll
    for (int i = 0; i < 2; ++i) { int R, C; stage_rc(tid * 16 + i * 8192, R, C); const int Rb = Epi::PERM ? ((R & ~31) + perm32(R & 31)) : R;
        voffA[i] = (unsigned)(R * K + C) * 2u; voffB[i] = (unsigned)(Rb * K + C) * 2u; }
    const size_t kstep = (size_t)(BK * 2);
    const size_t hstep = (size_t)HALF * K * 2;
    const size_t tstep = 2 * hstep;
    const unsigned ldsw = (unsigned)wid * 1024u;
    const int aoff = lds_byte(wr * 64 + fr, fq * 8), boff = lds_byte(wc * 32 + fr, fq * 8);
#define PG8_SA(b, h) (((b) * 2 + (h)) * HTB)
#define PG8_SB(b, h) ((4 + (b) * 2 + (h)) * HTB)
#define PG8_STAGE(bufoff, gbase, voff) do { _Pragma("unroll") for (int _i = 0; _i < 2; ++_i) { unsigned vo_ = (voff)[_i]; asm volatile("" : "+v"(vo_)); \
        __builtin_amdgcn_global_load_lds((const unsigned*)((const char*)(gbase) + vo_), (PG8_LAS unsigned*)(lds + (bufoff) + ldsw + _i * 8192), 16, 0, 0); } } while (0)
#define PG8_LD1(off) (*(const PG8_LAS bf16x8*)(lds + (off)))
#define PG8_LDA(dst, b, h) do { _Pragma("unroll") for (int m = 0; m < 4; ++m) { const int o_ = PG8_SA(b, h) + aoff + m * 2048; \
        if constexpr (Epi::FP8) dst[m].v = cat16(PG8_LD1(o_), PG8_LD1(o_ + 1024)); else { dst[m].k[0] = PG8_LD1(o_); dst[m].k[1] = PG8_LD1(o_ + 1024); } } } while (0)
#define PG8_LDB(dst, b, h) do { _Pragma("unroll") for (int n = 0; n < 2; ++n) { const int o_ = PG8_SB(b, h) + boff + n * 2048; \
        if constexpr (Epi::FP8) dst[n].v = cat16(PG8_LD1(o_), PG8_LD1(o_ + 1024)); else { dst[n].k[0] = PG8_LD1(o_); dst[n].k[1] = PG8_LD1(o_ + 1024); } } } while (0)
#define PG8_MMA(ai, bj, At, Bt) do { __builtin_amdgcn_s_setprio(1); _Pragma("unroll") for (int m = 0; m < 4; ++m) _Pragma("unroll") for (int n = 0; n < 2; ++n) { \
        if constexpr (Epi::FP8) asm volatile("v_mfma_f32_16x16x128_f8f6f4 %0, %1, %2, %0" : "+v"(acc[ai][bj][m][n]) : "v"(Bt[n].v), "v"(At[m].v));   \
        else { _Pragma("unroll") for (int k = 0; k < 2; ++k) acc[ai][bj][m][n] = __builtin_amdgcn_mfma_f32_16x16x32_bf16(Bt[n].k[k], At[m].k[k], acc[ai][bj][m][n], 0, 0, 0); } } \
        __builtin_amdgcn_s_setprio(0); } while (0)
#define PG8_WAIT_V(n) asm volatile("s_waitcnt vmcnt(" #n ")" ::: "memory")
#define PG8_WAIT_L(n) asm volatile("s_waitcnt lgkmcnt(" #n ")" ::: "memory")
#define PG8_BAR __builtin_amdgcn_s_barrier()
#define PG8_SCHED __builtin_amdgcn_sched_barrier(0)
    Unit cur, nxt; int ui = 0;
    if (!S.next(0, cur)) return;
    f32x4 acc[2][2][4][2];
#pragma unroll
    for (int a = 0; a < 2; ++a)
#pragma unroll
        for (int b = 0; b < 2; ++b)
#pragma unroll
            for (int m = 0; m < 4; ++m)
#pragma unroll
                for (int n = 0; n < 2; ++n) acc[a][b][m][n] = (f32x4){0.f, 0.f, 0.f, 0.f};
    Frag<Epi::FP8> At[4], B0[2], B1[2];
    const char* cA = (const char*)g.A + (size_t)cur.pm * tstep; const char* cB = (const char*)g.Bt + (size_t)cur.pn * tstep;
    S.a_ready(cur);
    PG8_STAGE(PG8_SB(0, 0), cB, voffB); PG8_STAGE(PG8_SA(0, 0), cA, voffA); PG8_STAGE(PG8_SB(0, 1), cB + hstep, voffB); PG8_STAGE(PG8_SA(0, 1), cA + hstep, voffA);
    if (wr == 1) PG8_BAR;
    PG8_WAIT_V(4); PG8_BAR;
    PG8_STAGE(PG8_SB(1, 0), cB + kstep, voffB); PG8_STAGE(PG8_SA(1, 0), cA + kstep, voffA); PG8_STAGE(PG8_SB(1, 1), cB + hstep + kstep, voffB);
    PG8_WAIT_V(6); PG8_BAR;
    PG8_STAMP();
    for (;;) {
        const bool has_next = S.next(ui + 1, nxt);
        const char* nA = has_next ? (const char*)g.A + (size_t)nxt.pm * tstep : cA; const char* nB = has_next ? (const char*)g.Bt + (size_t)nxt.pn * tstep : cB;
        for (int t = 0; t < nt; t += 2) {
            const bool last = (t == nt - 2);
            const char* a1 = cA + (size_t)(t + 1) * kstep;
            const char* a2 = last ? nA : cA + (size_t)(t + 2) * kstep; const char* b2 = last ? nB : cB + (size_t)(t + 2) * kstep;
            const char* a3 = a2 + kstep; const char* b3 = b2 + kstep;
            if (last && has_next) S.a_ready(nxt);
            PG8_LDB(B0, 0, 0); PG8_SCHED; PG8_LDA(At, 0, 0); PG8_STAGE(PG8_SA(1, 1), a1 + hstep, voffA);
            PG8_WAIT_L(8); PG8_BAR; PG8_WAIT_L(0); PG8_MMA(0, 0, At, B0); PG8_BAR; PG8_SCHED;
            PG8_LDB(B1, 0, 1); PG8_STAGE(PG8_SB(0, 0), b2, voffB);
            PG8_BAR; PG8_WAIT_L(0); PG8_MMA(0, 1, At, B1); PG8_BAR;
            PG8_LDA(At, 0, 1); PG8_STAGE(PG8_SA(0, 0), a2, voffA);
            PG8_BAR; PG8_WAIT_L(0); PG8_MMA(1, 0, At, B0); PG8_BAR; PG8_SCHED;
            PG8_STAGE(PG8_SB(0, 1), b2 + hstep, voffB);
            PG8_WAIT_V(6); PG8_BAR; PG8_MMA(1, 1, At, B1); PG8_BAR;
            PG8_LDB(B0, 1, 0); PG8_SCHED; PG8_LDA(At, 1, 0); PG8_STAGE(PG8_SA(0, 1), a2 + hstep, voffA);
            PG8_WAIT_L(8); PG8_BAR; PG8_WAIT_L(0); PG8_MMA(0, 0, At, B0); PG8_BAR; PG8_SCHED;
            PG8_LDB(B1, 1, 1); PG8_STAGE(PG8_SB(1, 0), b3, voffB);
            PG8_BAR; PG8_WAIT_L(0); PG8_MMA(0, 1, At, B1); PG8_BAR;
            PG8_LDA(At, 1, 1); PG8_STAGE(PG8_SA(1, 0), a3, voffA);
            PG8_BAR; PG8_WAIT_L(0); PG8_MMA(1, 0, At, B0); PG8_BAR; PG8_SCHED;
            PG8_STAGE(PG8_SB(1, 1), b3 + hstep, voffB);
            PG8_WAIT_V(6); PG8_BAR; PG8_MMA(1, 1, At, B1); PG8_BAR;
        }
        PG8_STAMP();
        if constexpr (Epi::FP8) asm volatile("s_nop 15\n\ts_nop 15\n\ts_nop 7" ::: "memory");
        if constexpr (!Epi::AFTER_DRAIN) { int te_ = threadIdx.x; asm volatile("" : "+v"(te_));
            const int fre_ = te_ & 15, fqe_ = (te_ & 63) >> 4; E(acc, cur, wr, wc, fre_, fqe_); S.done(cur); }
        PG8_STAMP();
        if (!has_next) break;
#pragma unroll
        for (int a = 0; a < 2; ++a)
#pragma unroll
            for (int b = 0; b < 2; ++b)
#pragma unroll
                for (int m = 0; m < 4; ++m)
#pragma unroll
                    for (int n = 0; n < 2; ++n) acc[a][b][m][n] = (f32x4){0.f, 0.f, 0.f, 0.f};
        cur = nxt; cA = nA; cB = nB; ++ui;
    }
    PG8_WAIT_V(0);
    if (wr == 0) PG8_BAR;
    PG8_BAR;
    if constexpr (Epi::AFTER_DRAIN) { E.fused(acc, cur, wr, wc, fr, fq, lds, wid, lane); S.done(cur); }
    PG8_STAMP();
    if (STAMP && wid == 0) { stamps[lane] = lane < nts ? (((unsigned long long)(unsigned)ts_hi << 32) | (unsigned)ts_lo) : 0ull;
        if (lane == 62) stamps[62] = rt_entry; if (lane == 63) stamps[63] = (unsigned long long)wall_clock64(); }
#undef PG8_STAMP
#undef PG8_SA
#undef PG8_SB
#undef PG8_STAGE
#undef PG8_LD1
#undef PG8_LDA
#undef PG8_LDB
#undef PG8_MMA
#undef PG8_WAIT_V
#undef PG8_WAIT_L
#undef PG8_BAR
#undef PG8_SCHED
}
}

namespace mk {
using pg8::bf16_t; using pg8::bf16x8; using pg8::f32x4; using pg8::u32x4; using pg8::Unit; using pg8::Gemm; using pg8::StaticOrder; using pg8::cvt_pk_bf16;
#define LAS __attribute__((address_space(3)))
typedef short bf16x4 __attribute__((ext_vector_type(4)));
typedef unsigned u32x2 __attribute__((ext_vector_type(2)));

constexpr int T_ALL = 12288, T_CTX = 8192, DM = 2048, NP = 15360, NIN = 16416;
constexpr int PQ = 0, PK = 1024, PZA = 2048, PBQ = 3072, PBK = 3584, PBV = 4096, PBZ = 5120, PCU = 6144, PCG = 7168, PCZ = 8192, PGA = 9216, PGB = 11264, PGC = 13312;
constexpr float ATT_SCALE = 0.08838834764831845f;
constexpr float ALPHA_DN = 1.4142135623730951f;
constexpr size_t OUT_Y = 0, OUT_K = 25165824ull, OUT_V = 41943040ull, OUT_S = 58720256ull;

constexpr size_t WS_CTL = 0;
constexpr size_t WS_MOD = 16384;
constexpr size_t WS_BTIN = 16384 + 147456;
constexpr int CTL_Q = 3584;
constexpr int RB = 3616;
constexpr size_t WS_BTBR = WS_BTIN + 2ull * RB * 2048 * 2;
constexpr size_t WS_BTOUT = WS_BTBR + 2ull * 6144 * 1024 * 2;
constexpr size_t WS_CK = WS_BTOUT + 2ull * 2048 * 2048 * 2;
constexpr size_t WS_CVT = WS_CK + 4ull * 256 * 1024 * 2;
constexpr size_t WS_H = WS_CVT + 4ull * 256 * 1024 * 2;
constexpr size_t WS_VT = WS_H + 12288ull * 2048 * 2;
constexpr size_t WS_LR = WS_VT + 1024ull * 12288 * 2;
constexpr size_t WS_YCAT = WS_LR + 12288ull * 32 * 4;
constexpr size_t WS_MRG = WS_YCAT + 3ull * 12288 * 1024 * 2;
constexpr size_t WS_X1 = WS_MRG + 12288ull * 2048 * 2;
constexpr size_t WS_OG = WS_X1 + 12288ull * 2048 * 4;
constexpr size_t WS_P = WS_OG + 2ull * 12288 * 1024 * 4;
constexpr size_t WS_SM = WS_P + 12288ull * 15360 * 2;
constexpr int SM_RPB = 0, SM_WG = 7680, SM_BGT = SM_WG + 32768, SM_NG = SM_BGT + 2048, SM_CW = SM_NG + 2048, SM_CB = SM_CW + 63488, SM_CNG = SM_CB + 2048, SM_CNB = SM_CNG + 2048,
    SM_LNG = SM_CNB + 2048, SM_LNB = SM_LNG + 4096, SM_ST = SM_LNB + 4096, SM_END = SM_ST + 1048576;
constexpr size_t WS_GST = WS_SM + (size_t)SM_END * 4;
constexpr size_t WS_BT8 = WS_GST + 1536ull * 53760;
constexpr int R8 = 15360;
constexpr size_t WS_H8 = WS_BT8 + 2ull * R8 * 2048;
constexpr size_t WS_END = WS_H8 + 12288ull * 2048;
constexpr int LDS_BYTES = 131072 + 1024;
constexpr int LDS_CTL = 131072;

struct Params {
    const float *x_prompt, *x_sample, *cache_k, *cache_v, *state_gla, *c, *c_ctx, *w_mod, *b_mod, *w_in, *rpb, *gla_w_gate, *gla_b_gate, *gla_norm_g,
        *conv_w, *conv_b, *conv_norm_g, *conv_norm_b, *w_proj_a, *w_proj_b, *w_proj_c, *w_out, *ln_g, *ln_b;
    float* out; unsigned char* ws;
};

__device__ __forceinline__ int otid() { int t = threadIdx.x; asm volatile("" : "+v"(t)); return t; }
#define GAS __attribute__((address_space(1)))
__device__ __forceinline__ unsigned char* ows(const Params& p) { GAS unsigned char* w = (GAS unsigned char*)p.ws; asm volatile("" : "+s"(w)); return (unsigned char*)w; }
__device__ __forceinline__ float bf2f(bf16_t b) { return __uint_as_float(((unsigned)b) << 16); }
__device__ __forceinline__ float bflo(unsigned w) { return __uint_as_float(w << 16); }
__device__ __forceinline__ float bfhi(unsigned w) { return __uint_as_float(w & 0xffff0000u); }
__device__ __forceinline__ bf16_t f2bf(float f) { unsigned u = __float_as_uint(f); u += 0x7FFFu + ((u >> 16) & 1u); return (bf16_t)(u >> 16); }
__device__ __forceinline__ float sigmoidf_(float x) { return 1.0f / (1.0f + __expf(-x)); }
__device__ __forceinline__ float siluf_(float x) { return x / (1.0f + __expf(-x)); }
template <int O> __device__ __forceinline__ float sxor(float v) { return __builtin_bit_cast(float, __builtin_amdgcn_ds_swizzle(__builtin_bit_cast(int, v), (O << 10) | 0x1F)); }
__device__ __forceinline__ float bperm(float v, int byte_index) { return __builtin_bit_cast(float, __builtin_amdgcn_ds_bpermute(byte_index, __builtin_bit_cast(int, v))); }
__device__ __forceinline__ float rlane(float v, int l) { return __builtin_bit_cast(float, __builtin_amdgcn_readlane(__builtin_bit_cast(int, v), l)); }
__device__ __forceinline__ float wsum(float v) { v += sxor<16>(v); v += sxor<8>(v); v += sxor<4>(v); v += sxor<2>(v); v += sxor<1>(v); return rlane(v, 0) + rlane(v, 32); }
__device__ __forceinline__ f32x4 mfma16(bf16x8 a, bf16x8 b, f32x4 c) { return __builtin_amdgcn_mfma_f32_16x16x32_bf16(a, b, c, 0, 0, 0); }

template <int NW> __device__ __forceinline__ void tr_tile(const float* src, size_t ld, bf16_t* dst, size_t dstK, LAS float* t) {
    const int tid = otid();
    constexpr int TPR = NW / 4, RPP = 512 / TPR, S = NW + 1;
#pragma unroll
    for (int it = 0; it < 128 / RPP; ++it) { const int k = it * RPP + tid / TPR, n4 = (tid % TPR) * 4; const float4 v = *(const float4*)(src + (size_t)k * ld + n4);
        t[k * S + n4] = v.x; t[k * S + n4 + 1] = v.y; t[k * S + n4 + 2] = v.z; t[k * S + n4 + 3] = v.w; }
    __syncthreads();
#pragma unroll
    for (int ps = 0; ps < NW / 32; ++ps) { const int n = ps * 32 + (tid >> 4), k8 = (tid & 15) * 8; u32x4 w;
        w.x = cvt_pk_bf16(t[(k8 + 0) * S + n], t[(k8 + 1) * S + n]); w.y = cvt_pk_bf16(t[(k8 + 2) * S + n], t[(k8 + 3) * S + n]);
        w.z = cvt_pk_bf16(t[(k8 + 4) * S + n], t[(k8 + 5) * S + n]); w.w = cvt_pk_bf16(t[(k8 + 6) * S + n], t[(k8 + 7) * S + n]);
        *(u32x4*)(dst + (size_t)n * dstK + k8) = w; }
    __syncthreads();
}
__device__ __forceinline__ unsigned pk4_fp8(float a, float b_, float c_, float d) { int w = 0; w = __builtin_amdgcn_cvt_pk_fp8_f32(a, b_, w, false); w = __builtin_amdgcn_cvt_pk_fp8_f32(c_, d, w, true); return (unsigned)w; }
__device__ __forceinline__ void tr_tile8(const float* src, size_t ld, unsigned char* dst, size_t dstK, LAS float* t) {
    const int tid = otid(); constexpr int S = 129;
#pragma unroll
    for (int it = 0; it < 8; ++it) { const int k = it * 16 + (tid >> 5), n4 = (tid & 31) * 4; const float4 v = *(const float4*)(src + (size_t)k * ld + n4);
        t[k * S + n4] = v.x; t[k * S + n4 + 1] = v.y; t[k * S + n4 + 2] = v.z; t[k * S + n4 + 3] = v.w; }
    __syncthreads();
#pragma unroll
    for (int ps = 0; ps < 4; ++ps) { const int n = ps * 32 + (tid >> 4), k8 = (tid & 15) * 8; u32x2 w;
        w.x = pk4_fp8(64.f * t[(k8 + 0) * S + n], 64.f * t[(k8 + 1) * S + n], 64.f * t[(k8 + 2) * S + n], 64.f * t[(k8 + 3) * S + n]);
        w.y = pk4_fp8(64.f * t[(k8 + 4) * S + n], 64.f * t[(k8 + 5) * S + n], 64.f * t[(k8 + 6) * S + n], 64.f * t[(k8 + 7) * S + n]);
        *(u32x2*)(dst + (size_t)n * dstK + k8) = w; }
    __syncthreads();
}
__device__ __forceinline__ int win_row(int n, bool& is8) {
    is8 = true;
    if (n < 1024) return n;
    if (n < 2048) { is8 = false; return n - 1024; }
    if (n < 3072) { is8 = false; return 2560 + (n - 2048); }
    if (n < 4096) return 1024 + (n - 3072);
    if (n < 4608) return 2048 + (n - 4096);
    if (n < 5120) { is8 = false; return 1024 + (n - 4608); }
    if (n < 6144) { is8 = false; return 1536 + (n - 5120); }
    if (n < 6176) { is8 = false; return 3584 + (n - 6144); }
    return 2560 + (n - 6176);
}
__device__ __forceinline__ void phase0(const Params p, LAS unsigned char* lds) {
    const int tid = otid(); unsigned char* ws = ows(p);
    LAS float* t = (LAS float*)lds;
    bf16_t* btin = (bf16_t*)(ws + WS_BTIN); bf16_t* btbr = (bf16_t*)(ws + WS_BTBR); bf16_t* btout = (bf16_t*)(ws + WS_BTOUT); bf16_t* cvt = (bf16_t*)(ws + WS_CVT);
    float* modp = (float*)(ws + WS_P);
    constexpr int J_MOD = 256, J_WIN = 2 * 128 * 16, J_LRW = 2 * 16, J_WBR = 2 * 3 * 128, J_WOUT = 2 * 256, J_CV = 4 * 16;
    for (int j = blockIdx.x; j < J_MOD + J_WIN + J_LRW + J_WBR + J_WOUT + J_CV; j += gridDim.x) {
        int q = j;
        if (q < J_MOD) {
            const int l = q >> 7, slab = q & 127, k0 = slab * 16;
            float acc[3][12];
#pragma unroll
            for (int v = 0; v < 3; ++v)
#pragma unroll
                for (int i = 0; i < 12; ++i) acc[v][i] = 0.f;
            for (int kk = 0; kk < 16; ++kk) { const int k = k0 + kk;
                const float s0 = siluf_(p.c_ctx[k]), s1 = siluf_(p.c[k]), s2 = siluf_(p.c[2048 + k]);
                const float* wr_ = p.w_mod + ((size_t)l * 2048 + k) * 6144 + tid * 4;
#pragma unroll
                for (int jx = 0; jx < 3; ++jx) { const float4 w = *(const float4*)(wr_ + jx * 2048);
                    acc[0][jx * 4 + 0] += s0 * w.x; acc[0][jx * 4 + 1] += s0 * w.y; acc[0][jx * 4 + 2] += s0 * w.z; acc[0][jx * 4 + 3] += s0 * w.w;
                    acc[1][jx * 4 + 0] += s1 * w.x; acc[1][jx * 4 + 1] += s1 * w.y; acc[1][jx * 4 + 2] += s1 * w.z; acc[1][jx * 4 + 3] += s1 * w.w;
                    acc[2][jx * 4 + 0] += s2 * w.x; acc[2][jx * 4 + 1] += s2 * w.y; acc[2][jx * 4 + 2] += s2 * w.z; acc[2][jx * 4 + 3] += s2 * w.w; } }
#pragma unroll
            for (int v = 0; v < 3; ++v)
#pragma unroll
                for (int jx = 0; jx < 3; ++jx) { float4 o; o.x = acc[v][jx * 4]; o.y = acc[v][jx * 4 + 1]; o.z = acc[v][jx * 4 + 2]; o.w = acc[v][jx * 4 + 3];
                    *(float4*)(modp + ((size_t)(l * 128 + slab) * 3 + v) * 6144 + jx * 2048 + tid * 4) = o; }
            continue;
        }
        q -= J_MOD;
        if (q < J_WIN) { const int l = q >> 11, rem = q & 2047, nt = rem >> 4, kt = rem & 15, n0 = nt < 48 ? nt * 128 : 6176 + (nt - 48) * 128, k0 = kt * 128;
            bool is8; const int drow = win_row(n0, is8);
            if (is8) tr_tile8(p.w_in + ((size_t)l * 2048 + k0) * NIN + n0, NIN, ws + WS_BT8 + ((size_t)l * R8 + drow) * 2048 + k0, 2048, t);
            else { tr_tile<128>(p.w_in + ((size_t)l * 2048 + k0) * NIN + n0, NIN, btin + ((size_t)l * RB + drow) * 2048 + k0, 2048, t);
                if (drow < 2560) tr_tile8(p.w_in + ((size_t)l * 2048 + k0) * NIN + n0, NIN, ws + WS_BT8 + ((size_t)l * R8 + 12800 + drow) * 2048 + k0, 2048, t); }
            continue; }
        q -= J_WIN;
        if (q < J_LRW) { const int l = q >> 4, kt = q & 15, k0 = kt * 128;
            tr_tile<32>(p.w_in + ((size_t)l * 2048 + k0) * NIN + 6144, NIN, btin + ((size_t)l * RB + 3584) * 2048 + k0, 2048, t); continue; }
        q -= J_LRW;
        if (q < J_WBR) { const int l = q / 384, rem = q % 384, br = rem >> 7, r2 = rem & 127, nt = r2 >> 3, kt = r2 & 7, n0 = nt * 128, k0 = kt * 128;
            const float* w = (br == 0 ? p.w_proj_a : (br == 1 ? p.w_proj_b : p.w_proj_c)) + (size_t)l * 1024 * 2048;
            tr_tile8(w + (size_t)k0 * 2048 + n0, 2048, ws + WS_BTBR + ((size_t)l * 6144 + br * 2048 + n0) * 1024 + k0, 1024, t); continue; }
        q -= J_WBR;
        if (q < J_WOUT) { const int l = q >> 8, rem = q & 255, nt = rem >> 4, kt = rem & 15, n0 = nt * 128, k0 = kt * 128;
            tr_tile8(p.w_out + ((size_t)l * 2048 + k0) * 2048 + n0, 2048, ws + WS_BTOUT + ((size_t)l * 2048 + n0) * 2048 + k0, 2048, t); continue; }
        q -= J_WOUT;
        { const int bl = q >> 4, rem = q & 15, nt = rem >> 1, kt = rem & 1, n0 = nt * 128, k0 = kt * 128;
            tr_tile<128>(p.cache_v + ((size_t)bl * 256 + k0) * 1024 + n0, 1024, cvt + ((size_t)bl * 1024 + n0) * 256 + k0, 256, t); }
    }
    { float* sm = (float*)(ws + WS_SM); const size_t g0 = (size_t)blockIdx.x * 512 + tid, gs = (size_t)gridDim.x * 512;
#define CPY(off, src, n) for (size_t i = g0; i < (size_t)(n); i += gs) sm[(off) + i] = (src)[i]
      CPY(SM_RPB, p.rpb, 7440); CPY(SM_WG, p.gla_w_gate, 32768); CPY(SM_BGT, p.gla_b_gate, 2048); CPY(SM_NG, p.gla_norm_g, 2048); CPY(SM_CW, p.conv_w, 63488); CPY(SM_CB, p.conv_b, 2048);
      CPY(SM_CNG, p.conv_norm_g, 2048); CPY(SM_CNB, p.conv_norm_b, 2048); CPY(SM_LNG, p.ln_g, 4096); CPY(SM_LNB, p.ln_b, 4096); CPY(SM_ST, p.state_gla, 1048576);
#undef CPY
    }
    bf16_t* ck = (bf16_t*)(ws + WS_CK);
    for (size_t i = (size_t)blockIdx.x * 512 + tid; i < 131072; i += (size_t)gridDim.x * 512) {
        const float4 a = *(const float4*)(p.cache_k + i * 8), b = *(const float4*)(p.cache_k + i * 8 + 4);
        u32x4 w; w.x = cvt_pk_bf16(a.x, a.y); w.y = cvt_pk_bf16(a.z, a.w); w.z = cvt_pk_bf16(b.x, b.y); w.w = cvt_pk_bf16(b.z, b.w);
        *(u32x4*)(ck + i * 8) = w; }
}
__device__ __forceinline__ void phase0b(const Params p) {
    const float* modp = (const float*)(ows(p) + WS_P); float* mod = (float*)(ows(p) + WS_MOD);
    for (int idx = blockIdx.x * 512 + otid(); idx < 36864; idx += gridDim.x * 512) {
        const int l = idx / 18432, rem = idx % 18432, v = rem / 6144, n = rem % 6144;
        float s = p.b_mod[l * 6144 + n];
#pragma unroll 8
        for (int sl = 0; sl < 128; ++sl) s += modp[((size_t)(l * 128 + sl) * 3 + v) * 6144 + n];
        mod[idx] = s; }
}

template <int MODE> __device__ __forceinline__ void ln_phase(const Params p, int l) {
    const int tid = otid(), wid = tid >> 6, lane = tid & 63;
    const float* Z = (const float*)(ows(p) + WS_P); float* X1 = (float*)(ows(p) + WS_X1); bf16_t* H = (bf16_t*)(ows(p) + WS_H); const float* mod = (const float*)(ows(p) + WS_MOD);
    for (int row = blockIdx.x * 8 + wid; row < T_ALL; row += gridDim.x * 8) {
        const float* src = (MODE == 0) ? (row < T_CTX ? p.x_prompt + (size_t)row * DM : p.x_sample + (size_t)(row - T_CTX) * DM) : Z + (size_t)row * DM;
        float4 v[8]; float s = 0.f;
#pragma unroll
        for (int j = 0; j < 8; ++j) { v[j] = *(const float4*)(src + j * 256 + lane * 4); s += (v[j].x + v[j].y) + (v[j].z + v[j].w); }
        float mean = wsum(s) * (1.0f / 2048.0f), q = 0.f;
#pragma unroll
        for (int j = 0; j < 8; ++j) { const float a = v[j].x - mean, b = v[j].y - mean, c = v[j].z - mean, d = v[j].w - mean; q += (a * a + b * b) + (c * c + d * d); }
        float rstd = rsqrtf(wsum(q) * (1.0f / 2048.0f) + 1e-5f);
        if (MODE >= 1) {
            const float* g = (const float*)(ows(p) + WS_SM) + SM_LNG + (size_t)(l - 1) * DM; const float* bb = (const float*)(ows(p) + WS_SM) + SM_LNB + (size_t)(l - 1) * DM;
            float* dst = (MODE == 2) ? p.out + OUT_Y + (size_t)row * DM : X1 + (size_t)row * DM; s = 0.f;
#pragma unroll
            for (int j = 0; j < 8; ++j) { const float4 gg = *(const float4*)(g + j * 256 + lane * 4), b4 = *(const float4*)(bb + j * 256 + lane * 4);
                v[j].x = (v[j].x - mean) * rstd * gg.x + b4.x; v[j].y = (v[j].y - mean) * rstd * gg.y + b4.y; v[j].z = (v[j].z - mean) * rstd * gg.z + b4.z; v[j].w = (v[j].w - mean) * rstd * gg.w + b4.w;
                *(float4*)(dst + j * 256 + lane * 4) = v[j]; s += (v[j].x + v[j].y) + (v[j].z + v[j].w); }
            if (MODE == 2) continue;
            mean = wsum(s) * (1.0f / 2048.0f); q = 0.f;
#pragma unroll
            for (int j = 0; j < 8; ++j) { const float a = v[j].x - mean, b = v[j].y - mean, c = v[j].z - mean, d = v[j].w - mean; q += (a * a + b * b) + (c * c + d * d); }
            rstd = rsqrtf(wsum(q) * (1.0f / 2048.0f) + 1e-5f);
        }
        const int vv = row < T_CTX ? 0 : 1 + ((row - T_CTX) >> 11);
        const float* md = mod + (size_t)(l * 3 + vv) * 6144;
#pragma unroll
        for (int j = 0; j < 8; ++j) { const float4 sh = *(const float4*)(md + j * 256 + lane * 4), sc = *(const float4*)(md + 2048 + j * 256 + lane * 4);
            u32x2 w; w.x = cvt_pk_bf16((v[j].x - mean) * rstd * (1.0f + sc.x) + sh.x, (v[j].y - mean) * rstd * (1.0f + sc.y) + sh.y);
            w.y = cvt_pk_bf16((v[j].z - mean) * rstd * (1.0f + sc.z) + sh.z, (v[j].w - mean) * rstd * (1.0f + sc.w) + sh.w);
            *(u32x2*)(H + (size_t)row * DM + j * 256 + lane * 4) = w;
            *(unsigned*)(ows(p) + WS_H8 + (size_t)row * DM + j * 256 + lane * 4) = pk4_fp8(bflo(w.x), bfhi(w.x), bflo(w.y), bfhi(w.y)); }
    }
}

__device__ __forceinline__ void lr_phase(const Params p, int l) {
    const int tid = otid(), wid = tid >> 6, lane = tid & 63, r = lane & 15, qd = lane >> 4;
    const bf16_t* H = (const bf16_t*)(ows(p) + WS_H); const bf16_t* bt = (const bf16_t*)(ows(p) + WS_BTIN) + ((size_t)l * RB + 3584) * 2048; float* LR = (float*)(ows(p) + WS_LR);
    for (int it = blockIdx.x * 8 + wid; it < T_ALL / 16; it += gridDim.x * 8) {
        const bf16_t* ap = H + (size_t)(it * 16 + r) * DM + qd * 8; const bf16_t* b0 = bt + (size_t)r * 2048 + qd * 8; const bf16_t* b1 = b0 + 16 * 2048;
        f32x4 c0 = {0.f, 0.f, 0.f, 0.f}, c1 = {0.f, 0.f, 0.f, 0.f};
#pragma unroll 8
        for (int ks = 0; ks < 64; ++ks) { const bf16x8 a = *(const bf16x8*)(ap + ks * 32); c0 = mfma16(a, *(const bf16x8*)(b0 + ks * 32), c0); c1 = mfma16(a, *(const bf16x8*)(b1 + ks * 32), c1); }
#pragma unroll
        for (int jj = 0; jj < 4; ++jj) { float* o = LR + (size_t)(it * 16 + qd * 4 + jj) * 32; o[r] = c0[jj]; o[16 + r] = c1[jj]; }
    }
}

template <bool F8> struct EpiInT {
    static constexpr bool PERM = true, AFTER_DRAIN = false, FP8 = F8;
    bf16_t* P; float* newk; int l;
    __device__ __forceinline__ void operator()(const f32x4 (&acc)[2][2][4][2], const Unit& u, int wr, int wc, int fr, int fq) const {
        const int j = u.pn;
        const int jb = F8 ? j - 50 : j;
        const int ptb = (jb < 4 ? 4 + jb : (jb < 6 ? 14 + (jb - 4) : 16 + (jb - 6)));
        const int pt = (F8 && j < 50) ? (j < 4 ? j : (j < 8 ? 8 + (j - 4) : (j < 10 ? 12 + (j - 8) : 20 + (j - 10)))) : ptb;
        const int row0 = u.pm * 256 + wr * 64 + fr, col0 = pt * 256 + wc * 32 + 8 * fq; const bool isk = !F8 && (j < 4) && (u.pm < 32);
        const float sc = F8 ? (1.0f / 64.0f) : 1.0f;
        const bool isg = F8 && (j < 50) && (pt >= 36);
#pragma unroll
        for (int ai = 0; ai < 2; ++ai)
#pragma unroll
            for (int m = 0; m < 4; ++m) { const int r = row0 + ai * 128 + m * 16;
#pragma unroll
                for (int bj = 0; bj < 2; ++bj) { const int c = col0 + bj * 128; const f32x4 v0 = acc[ai][bj][m][0] * sc, v1 = acc[ai][bj][m][1] * sc;
                    if (isg) { u32x2 w8; w8.x = pk4_fp8(v0[0], v0[1], v0[2], v0[3]); w8.y = pk4_fp8(v1[0], v1[1], v1[2], v1[3]); *(u32x2*)((unsigned char*)P + (size_t)r * NP * 2 + PGA * 2 + (c - PGA)) = w8; }
                    else { u32x4 w; w.x = cvt_pk_bf16(v0[0], v0[1]); w.y = cvt_pk_bf16(v0[2], v0[3]); w.z = cvt_pk_bf16(v1[0], v1[1]); w.w = cvt_pk_bf16(v1[2], v1[3]);
                    *(u32x4*)(P + (size_t)r * NP + c) = w; }
                    if (isk) { float* d = newk + ((size_t)((r >> 8) * 2 + l) * 256 + (r & 255)) * 1024 + (c - 1024); *(f32x4*)d = v0; *(f32x4*)(d + 4) = v1; } } }
    }
};
struct In8Order {
    StaticOrder so; int G, c;
    __device__ bool next(int i, Unit& u) const { const int L = i * G + c; if (L < 2400) return so.next(i, u); const int L2 = L - 2400; if (L2 >= 160) return false; u.pm = 32 + L2 / 10; u.pn = 50 + L2 % 10; return true; }
    __device__ __forceinline__ void a_ready(const Unit&) const {}
    __device__ __forceinline__ void done(const Unit&) const {}
};
struct EpiV {
    static constexpr bool PERM = true, AFTER_DRAIN = false, FP8 = false;
    bf16_t* VT; float* newv; int l;
    __device__ __forceinline__ void operator()(const f32x4 (&acc)[2][2][4][2], const Unit& u, int wr, int wc, int fr, int fq) const {
        const int row0 = u.pm * 256 + wr * 64 + fr, col0 = u.pn * 256 + wc * 32 + 8 * fq; const bool isv = u.pn < 32;
#pragma unroll
        for (int ai = 0; ai < 2; ++ai)
#pragma unroll
            for (int m = 0; m < 4; ++m) { const int r = row0 + ai * 128 + m * 16;
#pragma unroll
                for (int bj = 0; bj < 2; ++bj) { const int c = col0 + bj * 128; const f32x4 v0 = acc[ai][bj][m][0], v1 = acc[ai][bj][m][1];
                    u32x4 w; w.x = cvt_pk_bf16(v0[0], v0[1]); w.y = cvt_pk_bf16(v0[2], v0[3]); w.z = cvt_pk_bf16(v1[0], v1[1]); w.w = cvt_pk_bf16(v1[2], v1[3]);
                    *(u32x4*)(VT + (size_t)r * T_ALL + c) = w;
                    if (isv) { float* d = newv + ((size_t)((c >> 8) * 2 + l) * 256 + (c & 255)) * 1024 + r;
#pragma unroll
                        for (int j = 0; j < 4; ++j) { d[(size_t)j * 1024] = v0[j]; d[(size_t)(j + 4) * 1024] = v1[j]; } } } }
    }
};
struct BrOrder {
    StaticOrder so;
    __device__ bool next(int i, Unit& u) const { Unit t; if (!so.next(i, t)) return false; u.pm = t.pm; u.pn = (t.pm / 48) * 8 + t.pn; return true; }
    __device__ __forceinline__ void a_ready(const Unit&) const {}
    __device__ __forceinline__ void done(const Unit&) const {}
};
struct EpiBr {
    static constexpr bool PERM = true, AFTER_DRAIN = false, FP8 = true;
    bf16_t* B01; bf16_t* B2;
    __device__ __forceinline__ void operator()(const f32x4 (&acc)[2][2][4][2], const Unit& u, int wr, int wc, int fr, int fq) const {
        const int br = u.pm / 48, pm = u.pm - br * 48, pn = u.pn - br * 8;
        const int row0 = pm * 256 + wr * 64 + fr, col0 = pn * 256 + wc * 32 + 8 * fq; unsigned char* O = (br == 2) ? (unsigned char*)B2 : (unsigned char*)B01 + (size_t)br * T_ALL * DM;
#pragma unroll
        for (int ai = 0; ai < 2; ++ai)
#pragma unroll
            for (int m = 0; m < 4; ++m) { const int r = row0 + ai * 128 + m * 16;
#pragma unroll
                for (int bj = 0; bj < 2; ++bj) { const int c = col0 + bj * 128; const f32x4 v0 = acc[ai][bj][m][0] * 0.25f, v1 = acc[ai][bj][m][1] * 0.25f;
                    u32x2 w; w.x = pk4_fp8(v0[0], v0[1], v0[2], v0[3]); w.y = pk4_fp8(v1[0], v1[1], v1[2], v1[3]);
                    *(u32x2*)(O + (size_t)r * DM + c) = w; } }
    }
};
__device__ __forceinline__ void merge_phase(const Params p) {
    const int tid = otid(), wid = tid >> 6, lane = tid & 63;
    const bf16_t* P = (const bf16_t*)(ows(p) + WS_P); const bf16_t* B01 = (const bf16_t*)(ows(p) + WS_OG); const bf16_t* B2 = (const bf16_t*)(ows(p) + WS_H); bf16_t* MRG = (bf16_t*)(ows(p) + WS_MRG);
    for (int row = blockIdx.x * 8 + wid; row < T_ALL; row += gridDim.x * 8) {
#pragma unroll
        for (int j = 0; j < 4; ++j) { const int c = j * 512 + lane * 8; float a[8];
#pragma unroll
            for (int i = 0; i < 8; ++i) a[i] = 0.f;
#pragma unroll
            for (int br = 0; br < 3; ++br) { const unsigned char* bp = (br == 2 ? (const unsigned char*)B2 : (const unsigned char*)B01 + (size_t)br * T_ALL * DM) + (size_t)row * DM + c;
                const u32x2 x = *(const u32x2*)bp; const u32x2 g8 = *(const u32x2*)((const unsigned char*)P + (size_t)row * NP * 2 + PGA * 2 + br * 2048 + c);
                typedef float f32x2m __attribute__((ext_vector_type(2)));
                const f32x2m x01 = __builtin_amdgcn_cvt_pk_f32_fp8((int)x.x, false), x23 = __builtin_amdgcn_cvt_pk_f32_fp8((int)x.x, true), x45 = __builtin_amdgcn_cvt_pk_f32_fp8((int)x.y, false), x67 = __builtin_amdgcn_cvt_pk_f32_fp8((int)x.y, true);
                const f32x2m g01 = __builtin_amdgcn_cvt_pk_f32_fp8((int)g8.x, false), g23 = __builtin_amdgcn_cvt_pk_f32_fp8((int)g8.x, true), g45 = __builtin_amdgcn_cvt_pk_f32_fp8((int)g8.y, false), g67 = __builtin_amdgcn_cvt_pk_f32_fp8((int)g8.y, true);
                a[0] += x01.x * sigmoidf_(g01.x); a[1] += x01.y * sigmoidf_(g01.y); a[2] += x23.x * sigmoidf_(g23.x); a[3] += x23.y * sigmoidf_(g23.y);
                a[4] += x45.x * sigmoidf_(g45.x); a[5] += x45.y * sigmoidf_(g45.y); a[6] += x67.x * sigmoidf_(g67.x); a[7] += x67.y * sigmoidf_(g67.y); }
            u32x2 w; w.x = pk4_fp8(a[0] * 0.0625f, a[1] * 0.0625f, a[2] * 0.0625f, a[3] * 0.0625f); w.y = pk4_fp8(a[4] * 0.0625f, a[5] * 0.0625f, a[6] * 0.0625f, a[7] * 0.0625f);
            *(u32x2*)((unsigned char*)MRG + (size_t)row * DM + c) = w; } }
}
struct EpiOut {
    static constexpr bool PERM = false, AFTER_DRAIN = false, FP8 = true;
    const float *xp, *xs, *x1; const float* mod; float* Z; int l;
    __device__ __forceinline__ void operator()(const f32x4 (&acc)[2][2][4][2], const Unit& u, int wr, int wc, int fr, int fq) const {
        const int row0 = u.pm * 256 + wr * 64 + fr, col0 = u.pn * 256 + wc * 32 + 4 * fq;
#pragma unroll
        for (int ai = 0; ai < 2; ++ai)
#pragma unroll
            for (int m = 0; m < 4; ++m) { const int r = row0 + ai * 128 + m * 16;
                const float* x = (l == 0) ? (r < T_CTX ? xp + (size_t)r * DM : xs + (size_t)(r - T_CTX) * DM) : x1 + (size_t)r * DM;
                const int vv = r < T_CTX ? 0 : 1 + ((r - T_CTX) >> 11); const float* gt = mod + (size_t)(l * 3 + vv) * 6144 + 4096;
#pragma unroll
                for (int bj = 0; bj < 2; ++bj)
#pragma unroll
                    for (int n = 0; n < 2; ++n) { const int c = col0 + bj * 128 + n * 16; const f32x4 xv = *(const f32x4*)(x + c), gv = *(const f32x4*)(gt + c);
                        *(f32x4*)(Z + (size_t)r * DM + c) = ALPHA_DN * xv + gv * (acc[ai][bj][m][n] * (1.0f / 64.0f)); } }
    }
};

template <bool WIN> __device__ __forceinline__ void att_half(const bf16x8 (&qf)[4], const bf16_t* Kb, size_t kstride, const bf16_t* Vtb, size_t vstride, int tb0, int tbs,
                                                            f32x4 (&o)[8], float& m, float& lsum, int r, int qd, const float* rpb_h, int drbase, int qc, int bs) {
    f32x4 sc[16];
#pragma unroll
    for (int k4 = 0; k4 < 4; ++k4) {
        bf16x8 kf[4][4];
#pragma unroll
        for (int t = 0; t < 4; ++t) { const int kt = k4 * 4 + t; const int tok = tb0 + (kt >> 1) * tbs + (kt & 1) * 16 + r; const bf16_t* kp = Kb + (size_t)tok * kstride + qd * 8;
#pragma unroll
            for (int ks = 0; ks < 4; ++ks) kf[t][ks] = *(const bf16x8*)(kp + ks * 32); }
        asm volatile("" : "+v"(kf[0][0]), "+v"(kf[0][1]), "+v"(kf[0][2]), "+v"(kf[0][3]), "+v"(kf[1][0]), "+v"(kf[1][1]), "+v"(kf[1][2]), "+v"(kf[1][3]));
        asm volatile("" : "+v"(kf[2][0]), "+v"(kf[2][1]), "+v"(kf[2][2]), "+v"(kf[2][3]), "+v"(kf[3][0]), "+v"(kf[3][1]), "+v"(kf[3][2]), "+v"(kf[3][3]));
#pragma unroll
        for (int t = 0; t < 4; ++t) { f32x4 a = {0.f, 0.f, 0.f, 0.f};
#pragma unroll
            for (int ks = 0; ks < 4; ++ks) a = mfma16(kf[t][ks], qf[ks], a);
            sc[k4 * 4 + t] = a; }
        __builtin_amdgcn_sched_barrier(0);
    }
    float mx = m;
    const int cs = min(max(qc - 8, 0), 48);
#pragma unroll
    for (int kt = 0; kt < 16; ++kt)
#pragma unroll
        for (int jj = 0; jj < 4; ++jj) { float v = sc[kt][jj] * ATT_SCALE;
            if (WIN) { const int kc = bs + (kt & 1) * 16 + qd * 4 + jj; const bool valid = (kc >= cs) && (kc < cs + 16); const int dci = min(max(kc - qc + 15, 0), 30);
                const float bias = rpb_h[(drbase + (kt >> 1)) * 31 + dci]; v = valid ? v + bias : -1e30f; }
            sc[kt][jj] = v; mx = fmaxf(mx, v); }
    mx = fmaxf(mx, sxor<16>(mx)); mx = fmaxf(mx, bperm(mx, ((qd * 16 + r) ^ 32) << 2));
    const float alpha = __expf(m - mx); m = mx; lsum *= alpha;
#pragma unroll
    for (int dt = 0; dt < 8; ++dt) o[dt] *= alpha;
    unsigned pk[16][2];
#pragma unroll
    for (int kt = 0; kt < 16; ++kt) { const float p0 = __expf(sc[kt][0] - mx), p1 = __expf(sc[kt][1] - mx), p2 = __expf(sc[kt][2] - mx), p3 = __expf(sc[kt][3] - mx);
        lsum += (p0 + p1) + (p2 + p3); pk[kt][0] = cvt_pk_bf16(p0, p1); pk[kt][1] = cvt_pk_bf16(p2, p3); }
#pragma unroll
    for (int g = 0; g < 8; ++g) { u32x4 bw; bw.x = pk[2 * g][0]; bw.y = pk[2 * g][1]; bw.z = pk[2 * g + 1][0]; bw.w = pk[2 * g + 1][1];
        const bf16x8 b = __builtin_bit_cast(bf16x8, bw);
        bf16x4 lo[8], hi[8];
#pragma unroll
        for (int dt = 0; dt < 8; ++dt) { const bf16_t* vp = Vtb + (size_t)(dt * 16 + r) * vstride + tb0 + g * tbs + qd * 4; lo[dt] = *(const bf16x4*)vp; hi[dt] = *(const bf16x4*)(vp + 16); }
#pragma unroll
        for (int dt = 0; dt < 8; ++dt) o[dt] = mfma16(__builtin_shufflevector(lo[dt], hi[dt], 0, 1, 2, 3, 4, 5, 6, 7), b, o[dt]);
        if (g & 1) __builtin_amdgcn_sched_barrier(0); }
}
__device__ __forceinline__ void att_wave(const Params p, int l, bool latent, int b, int h, int tokq0, int row, int t16) {
    const int lane = otid() & 63, r = lane & 15, qd = lane >> 4;
    const bf16_t* P = (const bf16_t*)(ows(p) + WS_P); const bf16_t* VT = (const bf16_t*)(ows(p) + WS_VT); bf16_t* YA = (bf16_t*)(ows(p) + WS_YCAT);
    bf16x8 qf[4];
    { const bf16_t* qp = P + (size_t)(tokq0 + r) * NP + PQ + h * 128 + qd * 8;
#pragma unroll
        for (int ks = 0; ks < 4; ++ks) qf[ks] = *(const bf16x8*)(qp + ks * 32); }
    f32x4 o[8];
#pragma unroll
    for (int dt = 0; dt < 8; ++dt) o[dt] = (f32x4){0.f, 0.f, 0.f, 0.f};
    float m = -1e30f, lsum = 0.f;
    if (!latent) {
        att_half<false>(qf, P + (size_t)(b * 256) * NP + PK + h * 128, NP, VT + (size_t)(h * 128) * T_ALL + b * 256, T_ALL, 0, 32, o, m, lsum, r, qd, nullptr, 0, 0, 0);
    } else {
        const int rs = min(max(row - 4, 0), 24), bs = min(max(16 * t16 - 8, 0), 32), tokb = T_CTX + b * 2048;
        att_half<true>(qf, P + (size_t)tokb * NP + PK + h * 128, NP, VT + (size_t)(h * 128) * T_ALL + tokb, T_ALL, rs * 64 + bs, 64, o, m, lsum, r, qd,
                       (const float*)(ows(p) + WS_SM) + SM_RPB + (size_t)(l * 8 + h) * 15 * 31, rs - row + 7, t16 * 16 + r, bs);
        att_half<false>(qf, (const bf16_t*)(ows(p) + WS_CK) + (size_t)((b * 2 + l) * 256) * 1024 + h * 128, 1024,
                        (const bf16_t*)(ows(p) + WS_CVT) + (size_t)((b * 2 + l) * 1024 + h * 128) * 256, 256, 0, 32, o, m, lsum, r, qd, nullptr, 0, 0, 0);
    }
    lsum += sxor<16>(lsum); lsum += bperm(lsum, (lane ^ 32) << 2);
#if defined(PROBE_ZERO_LAT)
    const float inv = latent ? 0.f : 1.0f / lsum;
#elif defined(PROBE_ZERO_CTX)
    const float inv = latent ? 1.0f / lsum : 0.f;
#else
    const float inv = 1.0f / lsum;
#endif
    const size_t tok = (size_t)(tokq0 + r);
#pragma unroll
    for (int dt = 0; dt < 8; ++dt) { const int dim = h * 128 + dt * 16 + qd * 4; const u32x2 z = *(const u32x2*)(P + tok * NP + PZA + dim);
        *(unsigned*)((unsigned char*)YA + tok * 1024 + dim) = pk4_fp8(o[dt][0] * inv * siluf_(bflo(z.x)), o[dt][1] * inv * siluf_(bfhi(z.x)), o[dt][2] * inv * siluf_(bflo(z.y)), o[dt][3] * inv * siluf_(bfhi(z.y))); }
}

constexpr int G_QE = 0, G_KE = 17408, G_KLT = 34816, G_BL = 53248, G_VT = 53760, G_ATT = 90624, G_WG = 99840, G_BG = 108032;
constexpr int G_IMG = 53760;
__device__ __forceinline__ size_t gla_unit(bool latent, int b, int h, int dir, int c) { return latent ? (size_t)(1024 + ((b * 4 + h) * 2 + dir) * 32 + c) : (size_t)(((b * 4 + h) * 2 + dir) * 4 + c); }
__device__ __forceinline__ void gla_stage(const Params p, int l, bool latent, int b, int h, int dir, int c0, LAS unsigned char* lds) {
    const int tid = otid(), w = tid >> 6, lane = tid & 63;
    const int L = latent ? 2048 : 256, tok0 = latent ? T_CTX + b * 2048 : b * 256;
    const bf16_t* P = (const bf16_t*)(ows(p) + WS_P); const float* LR = (const float*)(ows(p) + WS_LR);
    LAS bf16_t* QE = (LAS bf16_t*)(lds + G_QE); LAS bf16_t* KE = (LAS bf16_t*)(lds + G_KE); LAS bf16_t* KLT = (LAS bf16_t*)(lds + G_KLT);
    LAS float* WG = (LAS float*)(lds + G_WG); LAS float* BG = (LAS float*)(lds + G_BG); LAS float* BL = (LAS float*)(lds + G_BL);
    for (int i = tid; i < 2048; i += 512) WG[i] = ((const float*)(ows(p) + WS_SM) + SM_WG)[((size_t)(l * 2 + dir) * 16 + (i >> 7)) * 512 + h * 128 + (i & 127)];
    if (tid < 128) BG[tid] = ((const float*)(ows(p) + WS_SM) + SM_BGT)[(size_t)(l * 2 + dir) * 512 + h * 128 + tid];
    __syncthreads();
    const int d0 = w * 16;
    for (int c = c0; c < c0 + 4; ++c) {
        { const int pos = c * 64 + lane; const int tl = dir ? (L - 1 - pos) : pos; const size_t tok = (size_t)(tok0 + tl); const bf16_t* prow = P + tok * NP;
            float lr[16];
            { const float4* lp = (const float4*)(LR + tok * 32 + dir * 16);
#pragma unroll
              for (int i = 0; i < 4; ++i) { const float4 t4 = lp[i]; lr[4 * i] = t4.x; lr[4 * i + 1] = t4.y; lr[4 * i + 2] = t4.z; lr[4 * i + 3] = t4.w; } }
#pragma unroll
            for (int hf = 0; hf < 4; ++hf) { const int dd = d0 + hf * 4;
                float qv[4], kv[4];
                { const u32x2 a0 = *(const u32x2*)(prow + PBQ + h * 128 + dd), b0 = *(const u32x2*)(prow + PBK + h * 128 + dd);
                  qv[0] = bflo(a0.x); qv[1] = bfhi(a0.x); qv[2] = bflo(a0.y); qv[3] = bfhi(a0.y); kv[0] = bflo(b0.x); kv[1] = bfhi(b0.x); kv[2] = bflo(b0.y); kv[3] = bfhi(b0.y); }
                if (latent) {
                    const int dp = dd ^ 32; float qp[4], kp2[4];
                    { const u32x2 a0 = *(const u32x2*)(prow + PBQ + h * 128 + dp), b0 = *(const u32x2*)(prow + PBK + h * 128 + dp);
                      qp[0] = bflo(a0.x); qp[1] = bfhi(a0.x); qp[2] = bflo(a0.y); qp[3] = bfhi(a0.y); kp2[0] = bflo(b0.x); kp2[1] = bfhi(b0.x); kp2[2] = bflo(b0.y); kp2[3] = bfhi(b0.y); }
                    const float posf = (float)((dd < 64) ? (tl >> 6) : (tl & 63)); const bool second = (dd & 32) != 0; const int f0 = dd & 31;
#pragma unroll
                    for (int i = 0; i < 4; ++i) { const float inv = __expf(-(float)(2 * (f0 + i)) * (9.210340371976184f / 64.0f)); const float ang = posf * inv; float sn, cn; __sincosf(ang, &sn, &cn);
                        const float q1 = second ? qp[i] : qv[i], q2 = second ? qv[i] : qp[i], k1 = second ? kp2[i] : kv[i], k2 = second ? kv[i] : kp2[i];
                        qv[i] = second ? (q1 * sn + q2 * cn) : (q1 * cn - q2 * sn); kv[i] = second ? (k1 * sn + k2 * cn) : (k1 * cn - k2 * sn); }
                }
                unsigned qe[2], ke[2];
#pragma unroll
                for (int i = 0; i < 4; ++i) { float g = BG[dd + i];
#pragma unroll
                    for (int rr = 0; rr < 16; ++rr) g += lr[rr] * WG[rr * 128 + dd + i];
                    float la = -(fmaxf(-g, 0.f) + __logf(1.0f + __expf(-fabsf(g)))) * (1.0f / 16.0f);
#pragma unroll
                    for (int off = 1; off < 64; off <<= 1) { const float t_ = bperm(la, ((lane - off) & 63) << 2); if (lane >= off) la += t_; }
                    const float bl = rlane(la, 63);
                    const float eb = __expf(la), enb = __expf(-la), elb = __expf(bl - la);
                    const float qq = qv[i] * ATT_SCALE * eb, kk = kv[i] * enb, kl = kv[i] * elb;
                    if (i & 1) { qe[i >> 1] = cvt_pk_bf16(__uint_as_float(qe[i >> 1]), qq); ke[i >> 1] = cvt_pk_bf16(__uint_as_float(ke[i >> 1]), kk); }
                    else { qe[i >> 1] = __float_as_uint(qq); ke[i >> 1] = __float_as_uint(kk); }
                    if (lane == 63) BL[dd + i] = __expf(bl);
                    KLT[(dd + i) * 72 + lane] = f2bf(kl); }
                { u32x2 w0; w0.x = qe[0]; w0.y = qe[1]; *(LAS u32x2*)(QE + lane * 136 + dd) = w0; w0.x = ke[0]; w0.y = ke[1]; *(LAS u32x2*)(KE + lane * 136 + dd) = w0; }
            }
        }
        __syncthreads();
        { u32x4* dst = (u32x4*)(ows(p) + WS_GST + gla_unit(latent, b, h, dir, c) * G_IMG);
          for (int i = tid; i < G_IMG / 16; i += 512) dst[i] = *(const LAS u32x4*)(lds + i * 16); }
        __syncthreads();
    }
}
#define LDS_BARRIER() do { asm volatile("s_waitcnt lgkmcnt(0)" ::: "memory"); __builtin_amdgcn_s_barrier(); asm volatile("" ::: "memory"); } while (0)
template <int NS> __device__ __forceinline__ void gla_item(const Params p, int l, bool latent, int b, int h, int dir, int sl, LAS unsigned char* lds) {
    constexpr int X = 2 / NS, NV = 4 / NS; constexpr bool PFE = (NS == 2);
    const int tid = otid(), w = tid >> 6, lane = tid & 63, r = lane & 15, qd = lane >> 4;
    const int L = latent ? 2048 : 256, nch = L >> 6, tok0 = latent ? T_CTX + b * 2048 : b * 256;
    const bf16_t* P = (const bf16_t*)(ows(p) + WS_P); float* OG = (float*)(ows(p) + WS_OG) + (size_t)dir * T_ALL * 1024;
    LAS bf16_t* QE = (LAS bf16_t*)(lds + G_QE); LAS bf16_t* KE = (LAS bf16_t*)(lds + G_KE); LAS bf16_t* KLT = (LAS bf16_t*)(lds + G_KLT); LAS bf16_t* VTs = (LAS bf16_t*)(lds + G_VT);
    LAS bf16_t* ATT = (LAS bf16_t*)(lds + G_ATT); LAS float* BL = (LAS float*)(lds + G_BL);
    const int et0 = (NS == 1) ? 2 * w : sl * 8 + w;
    const int eb = (NS == 1) ? w * 32 : sl * 128 + w * 16;
    f32x4 S[X][8];
    const size_t sidx = ((((size_t)(b * 2 + l) * 2 + dir) * 4 + h) * 128 + qd * 4) * 256 + et0 * 16 + r;
#pragma unroll
    for (int x = 0; x < X; ++x)
#pragma unroll
        for (int dt = 0; dt < 8; ++dt)
#pragma unroll
            for (int jj = 0; jj < 4; ++jj) S[x][dt][jj] = latent ? ((const float*)(ows(p) + WS_SM) + SM_ST)[sidx + (size_t)(dt * 16 + jj) * 256 + x * 16] : 0.f;
    u32x4 pf[7], vpf[NV];
#define GLA_PF_LOAD(cc) do { const u32x4* srcp_ = (const u32x4*)(ows(p) + WS_GST + gla_unit(latent, b, h, dir, (cc)) * G_IMG); \
        _Pragma("unroll") for (int k_ = 0; k_ < 7; ++k_) { const int i_ = tid + k_ * 512; if (i_ < G_IMG / 16) pf[k_] = srcp_[i_]; } \
        const int pos_ = (cc) * 64 + lane; const int tl_ = dir ? (L - 1 - pos_) : pos_; const bf16_t* prow_ = P + (size_t)(tok0 + tl_) * NP + PBV + h * 256 + eb; \
        _Pragma("unroll") for (int k4_ = 0; k4_ < NV; ++k4_) vpf[k4_] = *(const u32x4*)(prow_ + k4_ * 8); } while (0)
#define GLA_PF_STORE() do { \
        _Pragma("unroll") for (int k_ = 0; k_ < 7; ++k_) { const int i_ = tid + k_ * 512; if (i_ < G_IMG / 16) *(LAS u32x4*)(lds + i_ * 16) = pf[k_]; } \
        _Pragma("unroll") for (int k4_ = 0; k4_ < NV; ++k4_) { const unsigned vw_[4] = {vpf[k4_].x, vpf[k4_].y, vpf[k4_].z, vpf[k4_].w}; \
            _Pragma("unroll") for (int i_ = 0; i_ < 4; ++i_) { VTs[(eb + k4_ * 8 + 2 * i_) * 72 + lane] = (bf16_t)(vw_[i_] & 0xffffu); VTs[(eb + k4_ * 8 + 2 * i_ + 1) * 72 + lane] = (bf16_t)(vw_[i_] >> 16); } } } while (0)
    if (PFE) GLA_PF_LOAD(0);
    for (int c = 0; c < nch; ++c) {
        if (!PFE) GLA_PF_LOAD(c);
        GLA_PF_STORE();
        LDS_BARRIER();
        if (PFE && c + 1 < nch) GLA_PF_LOAD(c + 1);
#pragma unroll
        for (int x = 0; x < 2; ++x) { const int id = 2 * w + x, it = id >> 2, jt = id & 3; f32x4 a = {0.f, 0.f, 0.f, 0.f};
#pragma unroll
            for (int ks = 0; ks < 4; ++ks) a = mfma16(*(const LAS bf16x8*)(QE + (it * 16 + r) * 136 + ks * 32 + qd * 8), *(const LAS bf16x8*)(KE + (jt * 16 + r) * 136 + ks * 32 + qd * 8), a);
#pragma unroll
            for (int jj = 0; jj < 4; ++jj) { const int i = it * 16 + qd * 4 + jj, j = jt * 16 + r; ATT[i * 72 + j] = f2bf((dir ? i > j : i >= j) ? a[jj] : 0.f); } }
        LDS_BARRIER();
#pragma unroll
        for (int x = 0; x < X; ++x) { const int et = et0 + x;
            bf16x8 sb[4];
#pragma unroll
            for (int dp = 0; dp < 4; ++dp) { u32x4 t; t.x = cvt_pk_bf16(S[x][2 * dp][0], S[x][2 * dp][1]); t.y = cvt_pk_bf16(S[x][2 * dp][2], S[x][2 * dp][3]);
                t.z = cvt_pk_bf16(S[x][2 * dp + 1][0], S[x][2 * dp + 1][1]); t.w = cvt_pk_bf16(S[x][2 * dp + 1][2], S[x][2 * dp + 1][3]); sb[dp] = __builtin_bit_cast(bf16x8, t); }
            const bf16x8 v0 = *(const LAS bf16x8*)(VTs + (et * 16 + r) * 72 + qd * 8), v1 = *(const LAS bf16x8*)(VTs + (et * 16 + r) * 72 + 32 + qd * 8);
#pragma unroll 1
            for (int it = 0; it < 4; ++it) { f32x4 a = {0.f, 0.f, 0.f, 0.f};
                a = mfma16(*(const LAS bf16x8*)(ATT + (it * 16 + r) * 72 + qd * 8), v0, a); a = mfma16(*(const LAS bf16x8*)(ATT + (it * 16 + r) * 72 + 32 + qd * 8), v1, a);
#pragma unroll
                for (int dp = 0; dp < 4; ++dp) { const LAS bf16_t* qp_ = QE + (it * 16 + r) * 136 + dp * 32 + qd * 4;
                    const bf16x4 lo = *(const LAS bf16x4*)qp_, hi = *(const LAS bf16x4*)(qp_ + 16);
                    a = mfma16(__builtin_shufflevector(lo, hi, 0, 1, 2, 3, 4, 5, 6, 7), sb[dp], a); }
#pragma unroll
                for (int jj = 0; jj < 4; ++jj) { const int pos = c * 64 + it * 16 + qd * 4 + jj; const int tl = dir ? (L - 1 - pos) : pos;
                    OG[(size_t)(tok0 + tl) * 1024 + h * 256 + et * 16 + r] = a[jj]; } }
#pragma unroll
            for (int dt = 0; dt < 8; ++dt) { const f32x4 dec = *(const LAS f32x4*)(BL + dt * 16 + qd * 4); f32x4 s = S[x][dt] * dec;
                s = mfma16(*(const LAS bf16x8*)(KLT + (dt * 16 + r) * 72 + qd * 8), v0, s); s = mfma16(*(const LAS bf16x8*)(KLT + (dt * 16 + r) * 72 + 32 + qd * 8), v1, s);
                S[x][dt] = s; if (dt & 1) __builtin_amdgcn_sched_barrier(0); } }
        LDS_BARRIER();
    }
#undef GLA_PF_LOAD
#undef GLA_PF_STORE
    if (!latent) { float* so = p.out + OUT_S;
#pragma unroll
        for (int x = 0; x < X; ++x)
#pragma unroll
            for (int dt = 0; dt < 8; ++dt)
#pragma unroll
                for (int jj = 0; jj < 4; ++jj) so[sidx + (size_t)(dt * 16 + jj) * 256 + x * 16] = S[x][dt][jj]; }
}

__device__ __forceinline__ void conv_item(const Params p, int l, int item, LAS unsigned char* lds) {
    const int tid = otid(), wid = tid >> 6, lane = tid & 63; const int R0 = item * 16;
    const int s0 = R0 < T_CTX ? (R0 & ~255) : T_CTX + ((R0 - T_CTX) & ~2047), s1 = s0 + (R0 < T_CTX ? 256 : 2048);
    const bf16_t* P = (const bf16_t*)(ows(p) + WS_P); unsigned char* YC = ows(p) + WS_YCAT + 2ull * T_ALL * 1024;
    LAS bf16_t* U = (LAS bf16_t*)lds;
    LAS float* RED = (LAS float*)(lds + 94208);
    LAS float* STAT = (LAS float*)(lds + 94208 + 1024);
#pragma unroll
    for (int kb = 0; kb < 3; ++kb) { u32x4 av[4], gv[4];
#pragma unroll
        for (int kk = 0; kk < 4; ++kk) { const int i = min(tid + (kb * 4 + kk) * 512, 46 * 128 - 1); const int s = i >> 7, c8 = (i & 127) * 8; const int row = min(max(R0 - 15 + s, s0), s1 - 1);
            av[kk] = *(const u32x4*)(P + (size_t)row * NP + PCU + c8); gv[kk] = *(const u32x4*)(P + (size_t)row * NP + PCG + c8); }
#pragma unroll
        for (int kk = 0; kk < 4; ++kk) { const int i = tid + (kb * 4 + kk) * 512; const int s = i >> 7, c8 = (i & 127) * 8; const int row = R0 - 15 + s; const u32x4 a = av[kk], g = gv[kk]; u32x4 w;
            w.x = cvt_pk_bf16(bflo(a.x) * sigmoidf_(bflo(g.x)), bfhi(a.x) * sigmoidf_(bfhi(g.x))); w.y = cvt_pk_bf16(bflo(a.y) * sigmoidf_(bflo(g.y)), bfhi(a.y) * sigmoidf_(bfhi(g.y)));
            w.z = cvt_pk_bf16(bflo(a.z) * sigmoidf_(bflo(g.z)), bfhi(a.z) * sigmoidf_(bfhi(g.z))); w.w = cvt_pk_bf16(bflo(a.w) * sigmoidf_(bflo(g.w)), bfhi(a.w) * sigmoidf_(bfhi(g.w)));
            if (!(row >= s0 && row < s1)) w = (u32x4){0u, 0u, 0u, 0u};
            if (i < 46 * 128) *(LAS u32x4*)(U + s * 1024 + c8) = w; } }
    const int ch = tid * 2;
    typedef float f32x2 __attribute__((ext_vector_type(2)));
    f32x2 wv2[31];
#pragma unroll
    for (int j = 0; j < 31; ++j) wv2[j] = *(const f32x2*)((const float*)(ows(p) + WS_SM) + SM_CW + ((size_t)l * 31 + j) * 1024 + ch);
    const f32x2 cb = *(const f32x2*)((const float*)(ows(p) + WS_SM) + SM_CB + (size_t)l * 1024 + ch);
    f32x2 a2[16];
#pragma unroll
    for (int t = 0; t < 16; ++t) a2[t] = cb;
    __syncthreads();
#pragma unroll
    for (int s = 0; s < 46; ++s) { const unsigned uu = *(const LAS unsigned*)(U + s * 1024 + ch); const f32x2 u2 = {bflo(uu), bfhi(uu)};
#pragma unroll
        for (int t = 0; t < 16; ++t) { const int j = s - t; if (j >= 0 && j <= 30) a2[t] = __builtin_elementwise_fma(u2, wv2[j], a2[t]); } }
    float a0[16], a1[16];
#pragma unroll
    for (int t = 0; t < 16; ++t) { a0[t] = a2[t].x; a1[t] = a2[t].y; }
#pragma unroll
    for (int t = 0; t < 16; ++t) { const float sm = wsum(a0[t] + a1[t]), sq = wsum(a0[t] * a0[t] + a1[t] * a1[t]); if (lane == 0) { RED[(wid * 16 + t) * 2] = sm; RED[(wid * 16 + t) * 2 + 1] = sq; } }
    __syncthreads();
    if (tid < 16) { float sm = 0.f, sq = 0.f;
#pragma unroll
        for (int ww = 0; ww < 8; ++ww) { sm += RED[(ww * 16 + tid) * 2]; sq += RED[(ww * 16 + tid) * 2 + 1]; }
        const float mean = sm * (1.0f / 1024.0f), var = fmaxf(sq * (1.0f / 1024.0f) - mean * mean, 0.f); STAT[tid * 2] = mean; STAT[tid * 2 + 1] = rsqrtf(var + 1e-5f); }
    __syncthreads();
    const float2 gn = *(const float2*)((const float*)(ows(p) + WS_SM) + SM_CNG + (size_t)l * 1024 + ch), bn = *(const float2*)((const float*)(ows(p) + WS_SM) + SM_CNB + (size_t)l * 1024 + ch);
#pragma unroll
    for (int t = 0; t < 16; ++t) { const float mean = STAT[t * 2], rstd = STAT[t * 2 + 1]; const size_t row = (size_t)(R0 + t);
        const unsigned zz = *(const unsigned*)(P + row * NP + PCZ + ch);
        const float y0 = (a0[t] - mean) * rstd * gn.x + bn.x, y1 = (a1[t] - mean) * rstd * gn.y + bn.y;
        *(unsigned short*)(YC + row * 1024 + ch) = (unsigned short)(__builtin_amdgcn_cvt_pk_fp8_f32(siluf_(y0) * siluf_(bflo(zz)), siluf_(y1) * siluf_(bfhi(zz)), 0, false) & 0xffff); }
}

__device__ __forceinline__ void gla_stage_phase(const Params p, int l, LAS unsigned char* lds, int ci) {
    const int tid = otid();
    int cix = ci; asm volatile("" : "+s"(cix)); unsigned* ctr = (unsigned*)(ows(p) + WS_CTL + (size_t)(CTL_Q * 4)) + cix; volatile LAS int* slot = (volatile LAS int*)(lds + LDS_CTL);
    for (;;) {
        __syncthreads();
        if (tid == 0) *slot = (int)atomicAdd(ctr, 1u);
        __syncthreads();
        const int a = *slot;
        if (a >= 128 + 256) break;
        if (a < 128) gla_stage(p, l, true, a >> 6, (a >> 4) & 3, (a >> 3) & 1, (a & 7) * 4, lds);
        else { const int q = a - 128; gla_stage(p, l, false, q >> 3, (q >> 1) & 3, q & 1, 0, lds); }
    }
}
__device__ __forceinline__ void mix_phase(const Params p, int l, LAS unsigned char* lds, int ci) {
    const int tid = otid(), w = tid >> 6;
    int cix = ci; asm volatile("" : "+s"(cix)); unsigned* ctr = (unsigned*)(ows(p) + WS_CTL + (size_t)(CTL_Q * 4)) + cix; volatile LAS int* slot = (volatile LAS int*)(lds + LDS_CTL);
    constexpr int N_GL = 32, N_AC = 512, N_NA = 256, N_GC = 512, N_CV = 768, N_ALL = N_GL + N_AC + N_NA + N_GC + N_CV;
    for (;;) {
        __syncthreads();
        if (tid == 0) *slot = (int)atomicAdd(ctr, 1u);
        __syncthreads();
        int a = *slot;
        if (a >= N_ALL) break;
#ifndef SK_GLA
        if (a < N_GL) { gla_item<2>(p, l, true, a >> 4, (a >> 2) & 3, (a >> 1) & 1, a & 1, lds);
#ifdef DBL_GLAL
            gla_item<2>(p, l, true, a >> 4, (a >> 2) & 3, (a >> 1) & 1, a & 1, lds);
#endif
            continue; }
#endif
        a -= N_GL;
#ifndef SK_ATT
        if (a < N_AC) { const int bh = a >> 1, half = a & 1, b = bh >> 3, h = bh & 7; att_wave(p, l, false, b, h, b * 256 + (half * 8 + w) * 16, 0, 0);
#ifdef DBL_ATT
            att_wave(p, l, false, b, h, b * 256 + (half * 8 + w) * 16, 0, 0);
#endif
            continue; }
        a -= N_AC;
        if (a < N_NA) { const int b = a >> 7, h = (a >> 4) & 7, row = (a & 15) * 2 + (w >> 2), t16 = w & 3; att_wave(p, l, true, b, h, T_CTX + b * 2048 + row * 64 + t16 * 16, row, t16);
#ifdef DBL_NA
            att_wave(p, l, true, b, h, T_CTX + b * 2048 + row * 64 + t16 * 16, row, t16);
#endif
            continue; }
#endif
        a -= N_NA;
#ifndef SK_GLA
        if (a < N_GC) { gla_item<2>(p, l, false, a >> 4, (a >> 2) & 3, (a >> 1) & 1, a & 1, lds);
#ifdef DBL_GLAC
            gla_item<2>(p, l, false, a >> 4, (a >> 2) & 3, (a >> 1) & 1, a & 1, lds);
#endif
            continue; }
#endif
        a -= N_GC;
#ifndef SK_CONV
        conv_item(p, l, a, lds);
#ifdef DBL_CONV
        __syncthreads();
        conv_item(p, l, a, lds);
#endif
#endif
    }
}

__device__ __forceinline__ void post_phase(const Params p, int l) {
    const int tid = otid(), wid = tid >> 6, lane = tid & 63;
    const bf16_t* P = (const bf16_t*)(ows(p) + WS_P); const float* OG = (const float*)(ows(p) + WS_OG); unsigned char* YB = ows(p) + WS_YCAT + 1ull * T_ALL * 1024;
    for (int tok = blockIdx.x * 8 + wid; tok < T_ALL; tok += gridDim.x * 8) { const bf16_t* prow = P + (size_t)tok * NP;
#pragma unroll
        for (int h = 0; h < 4; ++h) {
            const int e = h * 256 + lane * 4;
            const f32x4 of = *(const f32x4*)(OG + (size_t)tok * 1024 + e), ob = *(const f32x4*)(OG + (size_t)(T_ALL + tok) * 1024 + e);
            const u32x2 z2 = *(const u32x2*)(prow + PBZ + e);
            const f32x4 o = of + ob;
            const float rs = rsqrtf(wsum((o[0] * o[0] + o[1] * o[1]) + (o[2] * o[2] + o[3] * o[3])) * (1.0f / 256.0f) + 1e-5f);
            const f32x4 g = *(const f32x4*)((const float*)(ows(p) + WS_SM) + SM_NG + (size_t)l * 1024 + e);
            *(unsigned*)(YB + (size_t)tok * 1024 + e) = pk4_fp8(o[0] * rs * g[0] * siluf_(bflo(z2.x)), o[1] * rs * g[1] * siluf_(bfhi(z2.x)), o[2] * rs * g[2] * siluf_(bflo(z2.y)), o[3] * rs * g[3] * siluf_(bfhi(z2.y))); } }
}


#define XB_TMO      128
#define XB_XCNT(j)  (256  + 64 * (j))
#define XB_XSUB(j)  (1280 + 64 * (j))
#define XB_XGEN(j)  (2304 + 64 * (j))
#define XB_TOP      3328
#define XB_TOPGEN   3392
#define XCD_BAR_WORDS 3456
#define XB_SPIN_CAP (1u << 18)

__device__ __forceinline__ unsigned xb_ld(unsigned* p)              { return __hip_atomic_load(p, __ATOMIC_RELAXED, __HIP_MEMORY_SCOPE_AGENT); }
__device__ __forceinline__ unsigned xb_add(unsigned* p, unsigned v) { return __hip_atomic_fetch_add(p, v, __ATOMIC_RELAXED, __HIP_MEMORY_SCOPE_AGENT); }
__device__ __forceinline__ unsigned xb_xcc_id() { return (unsigned)__builtin_amdgcn_readfirstlane((int)(__builtin_amdgcn_s_getreg((3 << 11) | 20) & 0xFu)); }
#define XB_SPIN(cond, bar) do { unsigned _sp = 0; while (cond) { __builtin_amdgcn_s_sleep(1); \
    if ((++_sp & 255u) == 0u) { if (xb_ld(&(bar)[XB_TMO])) break; if (_sp > XB_SPIN_CAP) { atomicAdd(&(bar)[XB_TMO], 1u); break; } } } } while (0)

struct XcdBarrier {
    unsigned* bar; unsigned x;
    volatile LAS unsigned* st;
};

__device__ __forceinline__ XcdBarrier xcd_barrier_post(unsigned* bar, volatile LAS unsigned* st) {
    XcdBarrier b; b.bar = bar; b.x = xb_xcc_id(); b.st = st;
    if (threadIdx.x == 0) (void)xb_add(&bar[XB_XCNT(b.x)], 1u);
    return b;
}
__device__ __forceinline__ void xcd_barrier_complete(unsigned* bar, unsigned x, unsigned& nloc, unsigned& nx) {
    const unsigned G = gridDim.x * gridDim.y * gridDim.z;
    unsigned sum, cnt, mine, sp = 0u;
    for (;;) {
        sum = 0u; cnt = 0u; mine = 0u;
#pragma unroll
        for (unsigned j = 0; j < 16; ++j) { const unsigned c = xb_ld(&bar[XB_XCNT(j)]); sum += c; cnt += (c > 0u) ? 1u : 0u; mine = (j == x) ? c : mine; }
        if (sum == G) break;
        __builtin_amdgcn_s_sleep(1);
        if ((++sp & 255u) == 0u) { if (xb_ld(&bar[XB_TMO])) break; if (sp > XB_SPIN_CAP) { atomicAdd(&bar[XB_TMO], 1u); break; } }
    }
    nloc = mine > 0u ? mine : 1u; nx = cnt > 0u ? cnt : 1u;
}

__device__ __forceinline__ void xcd_barrier(const XcdBarrier& b) {
    asm volatile("s_waitcnt vmcnt(0)" ::: "memory");
    __syncthreads();
    if (threadIdx.x == 0) {
        unsigned* bar = b.bar; const unsigned bx = xb_xcc_id();
        __builtin_amdgcn_s_waitcnt(0);
        unsigned nloc = b.st[0], nx = b.st[1];
        if (nloc == 0u) { xcd_barrier_complete(bar, bx, nloc, nx); b.st[0] = nloc; b.st[1] = nx; }
        const unsigned old = xb_add(&bar[XB_XSUB(bx)], 1u);
        const unsigned gen = old / nloc;
        if (old + 1u == (gen + 1u) * nloc) {
            __builtin_amdgcn_fence(__ATOMIC_RELEASE, "agent");
            asm volatile("s_waitcnt vmcnt(0)" ::: "memory");
            const unsigned og = xb_add(&bar[XB_TOP], 1u);
            const unsigned tg = og / nx;
            if (og + 1u == (tg + 1u) * nx) xb_add(&bar[XB_TOPGEN], 1u);
            else XB_SPIN(xb_ld(&bar[XB_TOPGEN]) == tg, bar);
            __builtin_amdgcn_fence(__ATOMIC_ACQUIRE, "agent");
            xb_add(&bar[XB_XGEN(bx)], 1u);
            asm volatile("s_waitcnt vmcnt(0)" ::: "memory");
        } else {
            XB_SPIN(xb_ld(&bar[XB_XGEN(bx)]) == gen, bar);
            __builtin_amdgcn_fence(__ATOMIC_ACQUIRE, "agent");
            asm volatile("s_waitcnt vmcnt(0)" ::: "memory");
        }
    }
    __syncthreads();
}

#ifdef DBL_SYNC
#define GRID_SYNC() do { xcd_barrier(xbar); xcd_barrier(xbar); } while (0)
#else
#define GRID_SYNC() xcd_barrier(xbar)
#endif
#define ws ows(p)
template <int LL> __device__ __forceinline__ void layer_body(const Params p, LAS unsigned char* lds, const XcdBarrier& xbar, const int c) {
    constexpr int l = LL;
#ifndef SK_LN
        if (l == 0) ln_phase<0>(p, 0); else ln_phase<1>(p, 1);
#ifdef DBL_LN
        if (l == 0) ln_phase<0>(p, 0);
#endif
#endif
        GRID_SYNC();
#ifndef SK_LR
        lr_phase(p, l);
#endif
#ifndef SK_IN
        { Gemm g; g.A = (const bf16_t*)(ws + WS_H); g.Bt = (const bf16_t*)(ws + WS_BTIN) + (size_t)l * RB * 2048; g.M = T_CTX; g.N = 2560; g.K = DM;
          StaticOrder so; so.init(T_CTX, 2560, gridDim.x, c);
          EpiInT<false> e; e.P = (bf16_t*)(ws + WS_P); e.newk = p.out + OUT_K; e.l = l;
          pg8::gemm_phase<EpiInT<false>, StaticOrder>(lds, g, so, e, nullptr); }
        { Gemm g; g.A = (const bf16_t*)(ws + WS_BTIN) + ((size_t)l * RB + 2560) * 2048; g.Bt = (const bf16_t*)(ws + WS_H); g.M = 1024; g.N = T_ALL; g.K = DM;
          StaticOrder so; so.init(1024, T_ALL, gridDim.x, (c + gridDim.x - 64) % gridDim.x);
          EpiV e; e.VT = (bf16_t*)(ws + WS_VT); e.newv = p.out + OUT_V; e.l = l;
          pg8::gemm_phase<EpiV, StaticOrder>(lds, g, so, e, nullptr); }
        { Gemm g; g.A = (const bf16_t*)(ws + WS_H8); g.Bt = (const bf16_t*)(ws + WS_BT8 + (size_t)l * R8 * 2048); g.M = T_ALL; g.N = R8; g.K = DM / 2;
          In8Order so; so.so.init(T_ALL, 12800, gridDim.x, c); so.G = gridDim.x; so.c = c;
          EpiInT<true> e; e.P = (bf16_t*)(ws + WS_P); e.newk = nullptr; e.l = l;
          pg8::gemm_phase<EpiInT<true>, In8Order>(lds, g, so, e, nullptr); }
#endif
        GRID_SYNC();
#ifndef SK_MIX
        gla_stage_phase(p, l, lds, 4 + l);
        GRID_SYNC();
        mix_phase(p, l, lds, l);
#ifdef DBL_MIX
        mix_phase(p, l, lds, 2 + l);
#endif
#endif
        GRID_SYNC();
#ifndef SK_POST
        post_phase(p, l);
#ifdef DBL_POST
        post_phase(p, l);
#endif
#endif
        GRID_SYNC();
#ifndef SK_BR
#ifdef DBL_BR
        for (int rep = 0; rep < 2; ++rep)
#endif
        { Gemm g; g.A = (const bf16_t*)(ws + WS_YCAT); g.Bt = (const bf16_t*)(ws + WS_BTBR + (size_t)l * 6144 * 1024); g.M = 3 * T_ALL; g.N = 3 * DM; g.K = 512;
          BrOrder bo; bo.so.init(3 * T_ALL, DM, gridDim.x, c);
          EpiBr e; e.B01 = (bf16_t*)(ws + WS_OG); e.B2 = (bf16_t*)(ws + WS_H);
          pg8::gemm_phase<EpiBr, BrOrder>(lds, g, bo, e, nullptr); }
        GRID_SYNC();
        merge_phase(p);
#endif
        GRID_SYNC();
        { Gemm g; g.A = (const bf16_t*)(ws + WS_MRG); g.Bt = (const bf16_t*)(ws + WS_BTOUT + (size_t)l * DM * DM); g.M = T_ALL; g.N = DM; g.K = DM / 2;
#ifndef SK_OUT
#ifdef DBL_OUT
          for (int rep = 0; rep < 2; ++rep) {
#else
          {
#endif
          StaticOrder so; so.init(T_ALL, DM, gridDim.x, c);
          EpiOut e; e.xp = p.x_prompt; e.xs = p.x_sample; e.x1 = (const float*)(ws + WS_X1); e.mod = (const float*)(ws + WS_MOD); e.Z = (float*)(ws + WS_P); e.l = l;
          pg8::gemm_phase<EpiOut, StaticOrder>(lds, g, so, e, nullptr); }
#endif
        }
        GRID_SYNC();
    }
#undef ws
__global__ void __launch_bounds__(512, 2) fwd_megakernel(Params p) {
    extern __shared__ __attribute__((aligned(16))) unsigned char smem[];
    LAS unsigned char* lds = (LAS unsigned char*)smem;
    cg::grid_group grid = cg::this_grid();
    const int c = blockIdx.x;
    if (threadIdx.x < 4) ((LAS unsigned*)(lds + LDS_CTL + 16))[threadIdx.x] = 0u;
    __syncthreads();
    const XcdBarrier xbar = xcd_barrier_post((unsigned*)(ows(p) + WS_CTL), (volatile LAS unsigned*)(lds + LDS_CTL + 16));
    if (p.out == nullptr) grid.sync();
    if (threadIdx.x == 0) { const unsigned x = xb_xcc_id(); const unsigned rk = atomicAdd((unsigned*)(ows(p) + WS_CTL) + CTL_Q + 16 + x, 1u);
        ((LAS unsigned*)(lds + LDS_CTL + 32))[0] = x; ((LAS unsigned*)(lds + LDS_CTL + 32))[1] = rk; }
#ifndef SK_P0
    phase0(p, lds);
#ifdef DBL_P0
    phase0(p, lds);
#endif
#endif
    GRID_SYNC();
    phase0b(p);
    GRID_SYNC();
    int ce = c;
    { unsigned* bar = (unsigned*)(ows(p) + WS_CTL); bool ok = (gridDim.x == 256);
#pragma unroll
      for (int j = 0; j < 16; ++j) ok = ok && (xb_ld(&bar[XB_XCNT(j)]) == (j < 8 ? 32u : 0u));
      const unsigned x = ((volatile LAS unsigned*)(lds + LDS_CTL + 32))[0], rk = ((volatile LAS unsigned*)(lds + LDS_CTL + 32))[1];
      if (ok && rk < 32u && x < 8u) ce = (int)(rk * 8u + x);
      ce = __builtin_amdgcn_readfirstlane(ce); }
    layer_body<0>(p, lds, xbar, ce);
    layer_body<1>(p, lds, xbar, ce);
    ln_phase<2>(p, 2);
}
}

extern "C" void kernel_launch(void* const* d_in, const int* in_sizes, int n_in, void* d_out, int out_size, void* d_ws, size_t ws_size, hipStream_t stream) {
    static int grid_blocks = 0;
    if (!grid_blocks) {
        int dev = 0, cus = 0, per_cu = 0;
        (void)hipGetDevice(&dev);
        (void)hipDeviceGetAttribute(&cus, hipDeviceAttributeMultiprocessorCount, dev);
        (void)hipFuncSetAttribute((const void*)mk::fwd_megakernel, hipFuncAttributeMaxDynamicSharedMemorySize, mk::LDS_BYTES);
        (void)hipOccupancyMaxActiveBlocksPerMultiprocessor(&per_cu, (const void*)mk::fwd_megakernel, 512, mk::LDS_BYTES);
        if (per_cu < 1) per_cu = 1;
        grid_blocks = cus * per_cu;
        if (ws_size < mk::WS_END || n_in != 24) fprintf(stderr, "kernel_launch: workspace %zu < %zu or n_in %d != 24\n", ws_size, (size_t)mk::WS_END, n_in);
    }
    (void)hipMemsetAsync(d_ws, 0, 16384, stream);
    mk::Params p{};
    const float** pp = (const float**)&p;
    for (int i = 0; i < 24; ++i) pp[i] = (const float*)d_in[i];
    p.out = (float*)d_out; p.ws = (unsigned char*)d_ws;
    void* args[] = {&p};
    hipError_t e = hipLaunchCooperativeKernel((void*)mk::fwd_megakernel, dim3(grid_blocks), dim3(512), args, mk::LDS_BYTES, stream);
    if (e != hipSuccess) fprintf(stderr, "cooperative launch failed: %s (grid %d)\n", hipGetErrorString(e), grid_blocks);
}
```

```cpp
#include <hip/hip_runtime.h>
#include <hip/hip_cooperative_groups.h>
#include <cstdio>
namespace cg = cooperative_groups;
namespace pg8 {
#define PG8_LAS __attribute__((address_space(3)))
typedef unsigned short bf16_t;
typedef short bf16x8 __attribute__((ext_vector_type(8)));
typedef float f32x4 __attribute__((ext_vector_type(4)));
typedef unsigned u32x4 __attribute__((ext_vector_type(4)));
constexpr int BM = 256, BK = 64, HALF = 128, HTB = HALF * BK * 2  , STAGE_BYTES = 8 * HTB, NXCD = 8, WGM = 8;

__host__ __device__ __forceinline__ int lds_byte(int r, int c) { const int st = (r >> 4) * 2 + (c >> 5), rr = r & 15, cc = c & 31, ob = rr * 64 + cc * 2; return st * 1024 + (ob ^ (((ob >> 9) & 1) << 5)); }
__host__ __device__ __forceinline__ void stage_rc(int b, int& R, int& C) { const int st = b / 1024, sb = b % 1024, swz = sb ^ (((sb >> 9) & 1) << 5); R = (st >> 1) * 16 + swz / 64; C = (st & 1) * 32 + (swz % 64) / 2; }
__host__ __device__ __forceinline__ int perm32(int rho) { const int n = rho >> 4, i = rho & 15; return 8 * (i >> 2) + 4 * n + (i & 3); }

typedef short s16x16_cat __attribute__((ext_vector_type(16))); typedef int v8i_cat __attribute__((ext_vector_type(8)));
__device__ __forceinline__ v8i_cat cat16(bf16x8 a, bf16x8 b) { const s16x16_cat t = __builtin_shufflevector(a, b, 0, 1, 2, 3, 4, 5, 6, 7, 8, 9, 10, 11, 12, 13, 14, 15); return __builtin_bit_cast(v8i_cat, t); }
template <bool F8> struct Frag;
template <> struct Frag<false> { bf16x8 k[2]; };
template <> struct Frag<true> { v8i_cat v; };
struct Unit { int pm, pn; };
struct Gemm { const bf16_t* A; const bf16_t* Bt; int M, N, K; };

struct StaticOrder {
    int nM, nN, nwg, G, c;
    __host__ __device__ void init(int M, int N, int G_, int c_) { nM = M / BM; nN = N / BM; nwg = nM * nN; G = G_; c = c_; }
    __host__ __device__ bool next(int i, Unit& u) const {
        const long L = (long)i * G + c; if (L >= nwg) return false;
        int wgid = (int)L; { const int q = nwg / NXCD, r = nwg % NXCD, xcd = wgid % NXCD, off = wgid / NXCD; wgid = (xcd < r ? xcd * (q + 1) : r * (q + 1) + (xcd - r) * q) + off; }
        const int nig = WGM * nN, gid = wgid / nig, fm = gid * WGM, gsz = (nM - fm) < WGM ? (nM - fm) : WGM;
        u.pm = fm + ((wgid % nig) % gsz); u.pn = (wgid % nig) / gsz; return true;
    }
    __device__ __forceinline__ void a_ready(const Unit&) const {}
    __device__ __forceinline__ void done(const Unit&) const {}
};
typedef float f32x2_cv __attribute__((ext_vector_type(2))); typedef __bf16 bf16x2_cv __attribute__((ext_vector_type(2)));
__device__ __forceinline__ unsigned cvt_pk_bf16(float lo, float hi) { const f32x2_cv v = {lo, hi}; return __builtin_bit_cast(unsigned, __builtin_convertvector(v, bf16x2_cv)); }
template <class Epi, class Sched, bool STAMP = false>
__device__ __forceinline__ void gemm_phase(PG8_LAS unsigned char* lds, const Gemm g, const Sched& S, const Epi& E, unsigned long long* stamps) {
    int tid_ = threadIdx.x; asm volatile("" : "+v"(tid_)); const int tid = tid_, wid = __builtin_amdgcn_readfirstlane(tid >> 6), lane = tid & 63, wr = wid >> 2, wc = wid & 3, fr = lane & 15, fq = lane >> 4;
    const int K = g.K, nt = K / BK;
    int ts_lo = 0, ts_hi = 0, nts = 0; const unsigned long long rt_entry = STAMP ? (unsigned long long)wall_clock64() : 0ull;
#define PG8_STAMP() do { if (STAMP && wid == 0 && nts < 64) { const unsigned long long _c = (unsigned long long)clock64(); \
        ts_lo = (lane == nts) ? (int)(unsigned)_c : ts_lo; ts_hi = (lane == nts) ? (int)(unsigned)(_c >> 32) : ts_hi; ++nts; } } while (0)
    PG8_STAMP();
    unsigned voffA[2], voffB[2];
#pragma unroll
    for (int i = 0; i < 2; ++i) { int R, C; stage_rc(tid * 16 + i * 8192, R, C); const int Rb = Epi::PERM ? ((R & ~31) + perm32(R & 31)) : R;
        voffA[i] = (unsigned)(R * K + C) * 2u; voffB[i] = (unsigned)(Rb * K + C) * 2u; }
    const size_t kstep = (size_t)(BK * 2);
    const size_t hstep = (size_t)HALF * K * 2;
    const size_t tstep = 2 * hstep;
    const unsigned ldsw = (unsigned)wid * 1024u;
    const int aoff = lds_byte(wr * 64 + fr, fq * 8), boff = lds_byte(wc * 32 + fr, fq * 8);
#define PG8_SA(b, h) (((b) * 2 + (h)) * HTB)
#define PG8_SB(b, h) ((4 + (b) * 2 + (h)) * HTB)
#define PG8_STAGE(bufoff, gbase, voff) do { _Pragma("unroll") for (int _i = 0; _i < 2; ++_i) { unsigned vo_ = (voff)[_i]; asm volatile("" : "+v"(vo_)); \
        __builtin_amdgcn_global_load_lds((const unsigned*)((const char*)(gbase) + vo_), (PG8_LAS unsigned*)(lds + (bufoff) + ldsw + _i * 8192), 16, 0, 0); } } while (0)
#define PG8_LD1(off) (*(const PG8_LAS bf16x8*)(lds + (off)))
#define PG8_LDA(dst, b, h) do { _Pragma("unroll") for (int m = 0; m < 4; ++m) { const int o_ = PG8_SA(b, h) + aoff + m * 2048; \
        if constexpr (Epi::FP8) dst[m].v = cat16(PG8_LD1(o_), PG8_LD1(o_ + 1024)); else { dst[m].k[0] = PG8_LD1(o_); dst[m].k[1] = PG8_LD1(o_ + 1024); } } } while (0)
#define PG8_LDB(dst, b, h) do { _Pragma("unroll") for (int n = 0; n < 2; ++n) { const int o_ = PG8_SB(b, h) + boff + n * 2048; \
        if constexpr (Epi::FP8) dst[n].v = cat16(PG8_LD1(o_), PG8_LD1(o_ + 1024)); else { dst[n].k[0] = PG8_LD1(o_); dst[n].k[1] = PG8_LD1(o_ + 1024); } } } while (0)
#define PG8_MMA(ai, bj, At, Bt) do { __builtin_amdgcn_s_setprio(1); _Pragma("unroll") for (int m = 0; m < 4; ++m) _Pragma("unroll") for (int n = 0; n < 2; ++n) { \
        if constexpr (Epi::FP8) asm volatile("v_mfma_f32_16x16x128_f8f6f4 %0, %1, %2, %0" : "+v"(acc[ai][bj][m][n]) : "v"(Bt[n].v), "v"(At[m].v));   \
        else { _Pragma("unroll") for (int k = 0; k < 2; ++k) acc[ai][bj][m][n] = __builtin_amdgcn_mfma_f32_16x16x32_bf16(Bt[n].k[k], At[m].k[k], acc[ai][bj][m][n], 0, 0, 0); } } \
        __builtin_amdgcn_s_setprio(0); } while (0)
#define PG8_WAIT_V(n) asm volatile("s_waitcnt vmcnt(" #n ")" ::: "memory")
#define PG8_WAIT_L(n) asm volatile("s_waitcnt lgkmcnt(" #n ")" ::: "memory")
#define PG8_BAR __builtin_amdgcn_s_barrier()
#define PG8_SCHED __builtin_amdgcn_sched_barrier(0)
    Unit cur, nxt; int ui = 0;
    if (!S.next(0, cur)) return;
    f32x4 acc[2][2][4][2];
#pragma unroll
    for (int a = 0; a < 2; ++a)
#pragma unroll
        for (int b = 0; b < 2; ++b)
#pragma unroll
            for (int m = 0; m < 4; ++m)
#pragma unroll
                for (int n = 0; n < 2; ++n) acc[a][b][m][n] = (f32x4){0.f, 0.f, 0.f, 0.f};
    Frag<Epi::FP8> At[4], B0[2], B1[2];
    const char* cA = (const char*)g.A + (size_t)cur.pm * tstep; const char* cB = (const char*)g.Bt + (size_t)cur.pn * tstep;
    S.a_ready(cur);
    PG8_STAGE(PG8_SB(0, 0), cB, voffB); PG8_STAGE(PG8_SA(0, 0), cA, voffA); PG8_STAGE(PG8_SB(0, 1), cB + hstep, voffB); PG8_STAGE(PG8_SA(0, 1), cA + hstep, voffA);
    if (wr == 1) PG8_BAR;
    PG8_WAIT_V(4); PG8_BAR;
    PG8_STAGE(PG8_SB(1, 0), cB + kstep, voffB); PG8_STAGE(PG8_SA(1, 0), cA + kstep, voffA); PG8_STAGE(PG8_SB(1, 1), cB + hstep + kstep, voffB);
    PG8_WAIT_V(6); PG8_BAR;
    PG8_STAMP();
    for (;;) {
        const bool has_next = S.next(ui + 1, nxt);
        const char* nA = has_next ? (const char*)g.A + (size_t)nxt.pm * tstep : cA; const char* nB = has_next ? (const char*)g.Bt + (size_t)nxt.pn * tstep : cB;
        for (int t = 0; t < nt; t += 2) {
            const bool last = (t == nt - 2);
            const char* a1 = cA + (size_t)(t + 1) * kstep;
            const char* a2 = last ? nA : cA + (size_t)(t + 2) * kstep; const char* b2 = last ? nB : cB + (size_t)(t + 2) * kstep;
            const char* a3 = a2 + kstep; const char* b3 = b2 + kstep;
            if (last && has_next) S.a_ready(nxt);
            PG8_LDB(B0, 0, 0); PG8_SCHED; PG8_LDA(At, 0, 0); PG8_STAGE(PG8_SA(1, 1), a1 + hstep, voffA);
            PG8_WAIT_L(8); PG8_BAR; PG8_WAIT_L(0); PG8_MMA(0, 0, At, B0); PG8_BAR; PG8_SCHED;
            PG8_LDB(B1, 0, 1); PG8_STAGE(PG8_SB(0, 0), b2, voffB);
            PG8_BAR; PG8_WAIT_L(0); PG8_MMA(0, 1, At, B1); PG8_BAR;
            PG8_LDA(At, 0, 1); PG8_STAGE(PG8_SA(0, 0), a2, voffA);
            PG8_BAR; PG8_WAIT_L(0); PG8_MMA(1, 0, At, B0); PG8_BAR; PG8_SCHED;
            PG8_STAGE(PG8_SB(0, 1), b2 + hstep, voffB);
            PG8_WAIT_V(6); PG8_BAR; PG8_MMA(1, 1, At, B1); PG8_BAR;
            PG8_LDB(B0, 1, 0); PG8_SCHED; PG8_LDA(At, 1, 0); PG8_STAGE(PG8_SA(0, 1), a2 + hstep, voffA);
            PG8_WAIT_L(8); PG8_BAR; PG8_WAIT_L(0); PG8_MMA(0, 0, At, B0); PG8_BAR; PG8_SCHED;
            PG8_LDB(B1, 1, 1); PG8_STAGE(PG8_SB(1, 0), b3, voffB);
            PG8_BAR; PG8_WAIT_L(0); PG8_MMA(0, 1, At, B1); PG8_BAR;
            PG8_LDA(At, 1, 1); PG8_STAGE(PG8_SA(1, 0), a3, voffA);
            PG8_BAR; PG8_WAIT_L(0); PG8_MMA(1, 0, At, B0); PG8_BAR; PG8_SCHED;
            PG8_STAGE(PG8_SB(1, 1), b3 + hstep, voffB);
            PG8_WAIT_V(6); PG8_BAR; PG8_MMA(1, 1, At, B1); PG8_BAR;
        }
        PG8_STAMP();
        if constexpr (Epi::FP8) asm volatile("s_nop 15\n\ts_nop 15\n\ts_nop 7" ::: "memory");
        if constexpr (!Epi::AFTER_DRAIN) { int te_ = threadIdx.x; asm volatile("" : "+v"(te_));
            const int fre_ = te_ & 15, fqe_ = (te_ & 63) >> 4; E(acc, cur, wr, wc, fre_, fqe_); S.done(cur); }
        PG8_STAMP();
        if (!has_next) break;
#pragma unroll
        for (int a = 0; a < 2; ++a)
#pragma unroll
            for (int b = 0; b < 2; ++b)
#pragma unroll
                for (int m = 0; m < 4; ++m)
#pragma unroll
                    for (int n = 0; n < 2; ++n) acc[a][b][m][n] = (f32x4){0.f, 0.f, 0.f, 0.f};
        cur = nxt; cA = nA; cB = nB; ++ui;
    }
    PG8_WAIT_V(0);
    if (wr == 0) PG8_BAR;
    PG8_BAR;
    if constexpr (Epi::AFTER_DRAIN) { E.fused(acc, cur, wr, wc, fr, fq, lds, wid, lane); S.done(cur); }
    PG8_STAMP();
    if (STAMP && wid == 0) { stamps[lane] = lane < nts ? (((unsigned long long)(unsigned)ts_hi << 32) | (unsigned)ts_lo) : 0ull;
        if (lane == 62) stamps[62] = rt_entry; if (lane == 63) stamps[63] = (unsigned long long)wall_clock64(); }
#undef PG8_STAMP
#undef PG8_SA
#undef PG8_SB
#undef PG8_STAGE
#undef PG8_LD1
#undef PG8_LDA
#undef PG8_LDB
#undef PG8_MMA
#undef PG8_WAIT_V
#undef PG8_WAIT_L
#undef PG8_BAR
#undef PG8_SCHED
}
}

namespace mk {
using pg8::bf16_t; using pg8::bf16x8; using pg8::f32x4; using pg8::u32x4; using pg8::Unit; using pg8::Gemm; using pg8::StaticOrder; using pg8::cvt_pk_bf16;
#define LAS __attribute__((address_space(3)))
typedef short bf16x4 __attribute__((ext_vector_type(4)));
typedef unsigned u32x2 __attribute__((ext_vector_type(2)));

constexpr int T_ALL = 12288, T_CTX = 8192, DM = 2048, NP = 15360, NIN = 16416;
constexpr int PQ = 0, PK = 1024, PZA = 2048, PBQ = 3072, PBK = 3584, PBV = 4096, PBZ = 5120, PCU = 6144, PCG = 7168, PCZ = 8192, PGA = 9216, PGB = 11264, PGC = 13312;
constexpr float ATT_SCALE = 0.08838834764831845f;
constexpr float ALPHA_DN = 1.4142135623730951f;
constexpr size_t OUT_Y = 0, OUT_K = 25165824ull, OUT_V = 41943040ull, OUT_S = 58720256ull;

constexpr size_t WS_CTL = 0;
constexpr size_t WS_MOD = 16384;
constexpr size_t WS_BTIN = 16384 + 147456;
constexpr int CTL_Q = 3584;
constexpr int RB = 3616;
constexpr size_t WS_BTBR = WS_BTIN + 2ull * RB * 2048 * 2;
constexpr size_t WS_BTOUT = WS_BTBR + 2ull * 6144 * 1024 * 2;
constexpr size_t WS_CK = WS_BTOUT + 2ull * 2048 * 2048 * 2;
constexpr size_t WS_CVT = WS_CK + 4ull * 256 * 1024 * 2;
constexpr size_t WS_H = WS_CVT + 4ull * 256 * 1024 * 2;
constexpr size_t WS_VT = WS_H + 12288ull * 2048 * 2;
constexpr size_t WS_LR = WS_VT + 1024ull * 12288 * 2;
constexpr size_t WS_YCAT = WS_LR + 12288ull * 32 * 4;
constexpr size_t WS_MRG = WS_YCAT + 3ull * 12288 * 1024 * 2;
constexpr size_t WS_X1 = WS_MRG + 12288ull * 2048 * 2;
constexpr size_t WS_OG = WS_X1 + 12288ull * 2048 * 4;
constexpr size_t WS_P = WS_OG + 2ull * 12288 * 1024 * 4;
constexpr size_t WS_SM = WS_P + 12288ull * 15360 * 2;
constexpr int SM_RPB = 0, SM_WG = 7680, SM_BGT = SM_WG + 32768, SM_NG = SM_BGT + 2048, SM_CW = SM_NG + 2048, SM_CB = SM_CW + 63488, SM_CNG = SM_CB + 2048, SM_CNB = SM_CNG + 2048,
    SM_LNG = SM_CNB + 2048, SM_LNB = SM_LNG + 4096, SM_ST = SM_LNB + 4096, SM_END = SM_ST + 1048576;
constexpr size_t WS_GST = WS_SM + (size_t)SM_END * 4;
constexpr size_t WS_BT8 = WS_GST + 1536ull * 53760;
constexpr int R8 = 15360;
constexpr size_t WS_H8 = WS_BT8 + 2ull * R8 * 2048;
constexpr size_t WS_END = WS_H8 + 12288ull * 2048;
constexpr int LDS_BYTES = 131072 + 1024;
constexpr int LDS_CTL = 131072;

struct Params {
    const float *x_prompt, *x_sample, *cache_k, *cache_v, *state_gla, *c, *c_ctx, *w_mod, *b_mod, *w_in, *rpb, *gla_w_gate, *gla_b_gate, *gla_norm_g,
        *conv_w, *conv_b, *conv_norm_g, *conv_norm_b, *w_proj_a, *w_proj_b, *w_proj_c, *w_out, *ln_g, *ln_b;
    float* out; unsigned char* ws;
};

__device__ __forceinline__ int otid() { int t = threadIdx.x; asm volatile("" : "+v"(t)); return t; }
#define GAS __attribute__((address_space(1)))
__device__ __forceinline__ unsigned char* ows(const Params& p) { GAS unsigned char* w = (GAS unsigned char*)p.ws; asm volatile("" : "+s"(w)); return (unsigned char*)w; }
__device__ __forceinline__ float bf2f(bf16_t b) { return __uint_as_float(((unsigned)b) << 16); }
__device__ __forceinline__ float bflo(unsigned w) { return __uint_as_float(w << 16); }
__device__ __forceinline__ float bfhi(unsigned w) { return __uint_as_float(w & 0xffff0000u); }
__device__ __forceinline__ bf16_t f2bf(float f) { unsigned u = __float_as_uint(f); u += 0x7FFFu + ((u >> 16) & 1u); return (bf16_t)(u >> 16); }
__device__ __forceinline__ float sigmoidf_(float x) { return 1.0f / (1.0f + __expf(-x)); }
__device__ __forceinline__ float siluf_(float x) { return x / (1.0f + __expf(-x)); }
template <int O> __device__ __forceinline__ float sxor(float v) { return __builtin_bit_cast(float, __builtin_amdgcn_ds_swizzle(__builtin_bit_cast(int, v), (O << 10) | 0x1F)); }
__device__ __forceinline__ float bperm(float v, int byte_index) { return __builtin_bit_cast(float, __builtin_amdgcn_ds_bpermute(byte_index, __builtin_bit_cast(int, v))); }
__device__ __forceinline__ float rlane(float v, int l) { return __builtin_bit_cast(float, __builtin_amdgcn_readlane(__builtin_bit_cast(int, v), l)); }
__device__ __forceinline__ float wsum(float v) { v += sxor<16>(v); v += sxor<8>(v); v += sxor<4>(v); v += sxor<2>(v); v += sxor<1>(v); return rlane(v, 0) + rlane(v, 32); }
__device__ __forceinline__ f32x4 mfma16(bf16x8 a, bf16x8 b, f32x4 c) { return __builtin_amdgcn_mfma_f32_16x16x32_bf16(a, b, c, 0, 0, 0); }

template <int NW> __device__ __forceinline__ void tr_tile(const float* src, size_t ld, bf16_t* dst, size_t dstK, LAS float* t) {
    const int tid = otid();
    constexpr int TPR = NW / 4, RPP = 512 / TPR, S = NW + 1;
#pragma unroll
    for (int it = 0; it < 128 / RPP; ++it) { const int k = it * RPP + tid / TPR, n4 = (tid % TPR) * 4; const float4 v = *(const float4*)(src + (size_t)k * ld + n4);
        t[k * S + n4] = v.x; t[k * S + n4 + 1] = v.y; t[k * S + n4 + 2] = v.z; t[k * S + n4 + 3] = v.w; }
    __syncthreads();
#pragma unroll
    for (int ps = 0; ps < NW / 32; ++ps) { const int n = ps * 32 + (tid >> 4), k8 = (tid & 15) * 8; u32x4 w;
        w.x = cvt_pk_bf16(t[(k8 + 0) * S + n], t[(k8 + 1) * S + n]); w.y = cvt_pk_bf16(t[(k8 + 2) * S + n], t[(k8 + 3) * S + n]);
        w.z = cvt_pk_bf16(t[(k8 + 4) * S + n], t[(k8 + 5) * S + n]); w.w = cvt_pk_bf16(t[(k8 + 6) * S + n], t[(k8 + 7) * S + n]);
        *(u32x4*)(dst + (size_t)n * dstK + k8) = w; }
    __syncthreads();
}
__device__ __forceinline__ unsigned pk4_fp8(float a, float b_, float c_, float d) { int w = 0; w = __builtin_amdgcn_cvt_pk_fp8_f32(a, b_, w, false); w = __builtin_amdgcn_cvt_pk_fp8_f32(c_, d, w, true); return (unsigned)w; }
__device__ __forceinline__ void tr_tile8(const float* src, size_t ld, unsigned char* dst, size_t dstK, LAS float* t) {
    const int tid = otid(); constexpr int S = 129;
#pragma unroll
    for (int it = 0; it < 8; ++it) { const int k = it * 16 + (tid >> 5), n4 = (tid & 31) * 4; const float4 v = *(const float4*)(src + (size_t)k * ld + n4);
        t[k * S + n4] = v.x; t[k * S + n4 + 1] = v.y; t[k * S + n4 + 2] = v.z; t[k * S + n4 + 3] = v.w; }
    __syncthreads();
#pragma unroll
    for (int ps = 0; ps < 4; ++ps) { const int n = ps * 32 + (tid >> 4), k8 = (tid & 15) * 8; u32x2 w;
        w.x = pk4_fp8(64.f * t[(k8 + 0) * S + n], 64.f * t[(k8 + 1) * S + n], 64.f * t[(k8 + 2) * S + n], 64.f * t[(k8 + 3) * S + n]);
        w.y = pk4_fp8(64.f * t[(k8 + 4) * S + n], 64.f * t[(k8 + 5) * S + n], 64.f * t[(k8 + 6) * S + n], 64.f * t[(k8 + 7) * S + n]);
        *(u32x2*)(dst + (size_t)n * dstK + k8) = w; }
    __syncthreads();
}
__device__ __forceinline__ int win_row(int n, bool& is8) {
    is8 = true;
    if (n < 1024) return n;
    if (n < 2048) { is8 = false; return n - 1024; }
    if (n < 3072) { is8 = false; return 2560 + (n - 2048); }
    if (n < 4096) return 1024 + (n - 3072);
    if (n < 4608) return 2048 + (n - 4096);
    if (n < 5120) { is8 = false; return 1024 + (n - 4608); }
    if (n < 6144) { is8 = false; return 1536 + (n - 5120); }
    if (n < 6176) { is8 = false; return 3584 + (n - 6144); }
    return 2560 + (n - 6176);
}
__device__ __forceinline__ void phase0(const Params p, LAS unsigned char* lds) {
    const int tid = otid(); unsigned char* ws = ows(p);
    LAS float* t = (LAS float*)lds;
    bf16_t* btin = (bf16_t*)(ws + WS_BTIN); bf16_t* btbr = (bf16_t*)(ws + WS_BTBR); bf16_t* btout = (bf16_t*)(ws + WS_BTOUT); bf16_t* cvt = (bf16_t*)(ws + WS_CVT);
    float* modp = (float*)(ws + WS_P);
    constexpr int J_MOD = 256, J_WIN = 2 * 128 * 16, J_LRW = 2 * 16, J_WBR = 2 * 3 * 128, J_WOUT = 2 * 256, J_CV = 4 * 16;
    for (int j = blockIdx.x; j < J_MOD + J_WIN + J_LRW + J_WBR + J_WOUT + J_CV; j += gridDim.x) {
        int q = j;
        if (q < J_MOD) {
            const int l = q >> 7, slab = q & 127, k0 = slab * 16;
            float acc[3][12];
#pragma unroll
            for (int v = 0; v < 3; ++v)
#pragma unroll
                for (int i = 0; i < 12; ++i) acc[v][i] = 0.f;
            for (int kk = 0; kk < 16; ++kk) { const int k = k0 + kk;
                const float s0 = siluf_(p.c_ctx[k]), s1 = siluf_(p.c[k]), s2 = siluf_(p.c[2048 + k]);
                const float* wr_ = p.w_mod + ((size_t)l * 2048 + k) * 6144 + tid * 4;
#pragma unroll
                for (int jx = 0; jx < 3; ++jx) { const float4 w = *(const float4*)(wr_ + jx * 2048);
                    acc[0][jx * 4 + 0] += s0 * w.x; acc[0][jx * 4 + 1] += s0 * w.y; acc[0][jx * 4 + 2] += s0 * w.z; acc[0][jx * 4 + 3] += s0 * w.w;
                    acc[1][jx * 4 + 0] += s1 * w.x; acc[1][jx * 4 + 1] += s1 * w.y; acc[1][jx * 4 + 2] += s1 * w.z; acc[1][jx * 4 + 3] += s1 * w.w;
                    acc[2][jx * 4 + 0] += s2 * w.x; acc[2][jx * 4 + 1] += s2 * w.y; acc[2][jx * 4 + 2] += s2 * w.z; acc[2][jx * 4 + 3] += s2 * w.w; } }
#pragma unroll
            for (int v = 0; v < 3; ++v)
#pragma unroll
                for (int jx = 0; jx < 3; ++jx) { float4 o; o.x = acc[v][jx * 4]; o.y = acc[v][jx * 4 + 1]; o.z = acc[v][jx * 4 + 2]; o.w = acc[v][jx * 4 + 3];
                    *(float4*)(modp + ((size_t)(l * 128 + slab) * 3 + v) * 6144 + jx * 2048 + tid * 4) = o; }
            continue;
        }
        q -= J_MOD;
        if (q < J_WIN) { const int l = q >> 11, rem = q & 2047, nt = rem >> 4, kt = rem & 15, n0 = nt < 48 ? nt * 128 : 6176 + (nt - 48) * 128, k0 = kt * 128;
            bool is8; const int drow = win_row(n0, is8);
            if (is8) tr_tile8(p.w_in + ((size_t)l * 2048 + k0) * NIN + n0, NIN, ws + WS_BT8 + ((size_t)l * R8 + drow) * 2048 + k0, 2048, t);
            else { tr_tile<128>(p.w_in + ((size_t)l * 2048 + k0) * NIN + n0, NIN, btin + ((size_t)l * RB + drow) * 2048 + k0, 2048, t);
                if (drow < 2560) tr_tile8(p.w_in + ((size_t)l * 2048 + k0) * NIN + n0, NIN, ws + WS_BT8 + ((size_t)l * R8 + 12800 + drow) * 2048 + k0, 2048, t); }
            continue; }
        q -= J_WIN;
        if (q < J_LRW) { const int l = q >> 4, kt = q & 15, k0 = kt * 128;
            tr_tile<32>(p.w_in + ((size_t)l * 2048 + k0) * NIN + 6144, NIN, btin + ((size_t)l * RB + 3584) * 2048 + k0, 2048, t); continue; }
        q -= J_LRW;
        if (q < J_WBR) { const int l = q / 384, rem = q % 384, br = rem >> 7, r2 = rem & 127, nt = r2 >> 3, kt = r2 & 7, n0 = nt * 128, k0 = kt * 128;
            const float* w = (br == 0 ? p.w_proj_a : (br == 1 ? p.w_proj_b : p.w_proj_c)) + (size_t)l * 1024 * 2048;
            tr_tile8(w + (size_t)k0 * 2048 + n0, 2048, ws + WS_BTBR + ((size_t)l * 6144 + br * 2048 + n0) * 1024 + k0, 1024, t); continue; }
        q -= J_WBR;
        if (q < J_WOUT) { const int l = q >> 8, rem = q & 255, nt = rem >> 4, kt = rem & 15, n0 = nt * 128, k0 = kt * 128;
            tr_tile8(p.w_out + ((size_t)l * 2048 + k0) * 2048 + n0, 2048, ws + WS_BTOUT + ((size_t)l * 2048 + n0) * 2048 + k0, 2048, t); continue; }
        q -= J_WOUT;
        { const int bl = q >> 4, rem = q & 15, nt = rem >> 1, kt = rem & 1, n0 = nt * 128, k0 = kt * 128;
            tr_tile<128>(p.cache_v + ((size_t)bl * 256 + k0) * 1024 + n0, 1024, cvt + ((size_t)bl * 1024 + n0) * 256 + k0, 256, t); }
    }
    { float* sm = (float*)(ws + WS_SM); const size_t g0 = (size_t)blockIdx.x * 512 + tid, gs = (size_t)gridDim.x * 512;
#define CPY(off, src, n) for (size_t i = g0; i < (size_t)(n); i += gs) sm[(off) + i] = (src)[i]
      CPY(SM_RPB, p.rpb, 7440); CPY(SM_WG, p.gla_w_gate, 32768); CPY(SM_BGT, p.gla_b_gate, 2048); CPY(SM_NG, p.gla_norm_g, 2048); CPY(SM_CW, p.conv_w, 63488); CPY(SM_CB, p.conv_b, 2048);
      CPY(SM_CNG, p.conv_norm_g, 2048); CPY(SM_CNB, p.conv_norm_b, 2048); CPY(SM_LNG, p.ln_g, 4096); CPY(SM_LNB, p.ln_b, 4096); CPY(SM_ST, p.state_gla, 1048576);
#undef CPY
    }
    bf16_t* ck = (bf16_t*)(ws + WS_CK);
    for (size_t i = (size_t)blockIdx.x * 512 + tid; i < 131072; i += (size_t)gridDim.x * 512) {
        const float4 a = *(const float4*)(p.cache_k + i * 8), b = *(const float4*)(p.cache_k + i * 8 + 4);
        u32x4 w; w.x = cvt_pk_bf16(a.x, a.y); w.y = cvt_pk_bf16(a.z, a.w); w.z = cvt_pk_bf16(b.x, b.y); w.w = cvt_pk_bf16(b.z, b.w);
        *(u32x4*)(ck + i * 8) = w; }
}
__device__ __forceinline__ void phase0b(const Params p) {
    const float* modp = (const float*)(ows(p) + WS_P); float* mod = (float*)(ows(p) + WS_MOD);
    for (int idx = blockIdx.x * 512 + otid(); idx < 36864; idx += gridDim.x * 512) {
        const int l = idx / 18432, rem = idx % 18432, v = rem / 6144, n = rem % 6144;
        float s = p.b_mod[l * 6144 + n];
#pragma unroll 8
        for (int sl = 0; sl < 128; ++sl) s += modp[((size_t)(l * 128 + sl) * 3 + v) * 6144 + n];
        mod[idx] = s; }
}

template <int MODE> __device__ __forceinline__ void ln_phase(const Params p, int l) {
    const int tid = otid(), wid = tid >> 6, lane = tid & 63;
    const float* Z = (const float*)(ows(p) + WS_P); float* X1 = (float*)(ows(p) + WS_X1); bf16_t* H = (bf16_t*)(ows(p) + WS_H); const float* mod = (const float*)(ows(p) + WS_MOD);
    for (int row = blockIdx.x * 8 + wid; row < T_ALL; row += gridDim.x * 8) {
        const float* src = (MODE == 0) ? (row < T_CTX ? p.x_prompt + (size_t)row * DM : p.x_sample + (size_t)(row - T_CTX) * DM) : Z + (size_t)row * DM;
        float4 v[8]; float s = 0.f;
#pragma unroll
        for (int j = 0; j < 8; ++j) { v[j] = *(const float4*)(src + j * 256 + lane * 4); s += (v[j].x + v[j].y) + (v[j].z + v[j].w); }
        float mean = wsum(s) * (1.0f / 2048.0f), q = 0.f;
#pragma unroll
        for (int j = 0; j < 8; ++j) { const float a = v[j].x - mean, b = v[j].y - mean, c = v[j].z - mean, d = v[j].w - mean; q += (a * a + b * b) + (c * c + d * d); }
        float rstd = rsqrtf(wsum(q) * (1.0f / 2048.0f) + 1e-5f);
        if (MODE >= 1) {
            const float* g = (const float*)(ows(p) + WS_SM) + SM_LNG + (size_t)(l - 1) * DM; const float* bb = (const float*)(ows(p) + WS_SM) + SM_LNB + (size_t)(l - 1) * DM;
            float* dst = (MODE == 2) ? p.out + OUT_Y + (size_t)row * DM : X1 + (size_t)row * DM; s = 0.f;
#pragma unroll
            for (int j = 0; j < 8; ++j) { const float4 gg = *(const float4*)(g + j * 256 + lane * 4), b4 = *(const float4*)(bb + j * 256 + lane * 4);
                v[j].x = (v[j].x - mean) * rstd * gg.x + b4.x; v[j].y = (v[j].y - mean) * rstd * gg.y + b4.y; v[j].z = (v[j].z - mean) * rstd * gg.z + b4.z; v[j].w = (v[j].w - mean) * rstd * gg.w + b4.w;
                *(float4*)(dst + j * 256 + lane * 4) = v[j]; s += (v[j].x + v[j].y) + (v[j].z + v[j].w); }
            if (MODE == 2) continue;
            mean = wsum(s) * (1.0f / 2048.0f); q = 0.f;
#pragma unroll
            for (int j = 0; j < 8; ++j) { const float a = v[j].x - mean, b = v[j].y - mean, c = v[j].z - mean, d = v[j].w - mean; q += (a * a + b * b) + (c * c + d * d); }
            rstd = rsqrtf(wsum(q) * (1.0f / 2048.0f) + 1e-5f);
        }
        const int vv = row < T_CTX ? 0 : 1 + ((row - T_CTX) >> 11);
        const float* md = mod + (size_t)(l * 3 + vv) * 6144;
#pragma unroll
        for (int j = 0; j < 8; ++j) { const float4 sh = *(const float4*)(md + j * 256 + lane * 4), sc = *(const float4*)(md + 2048 + j * 256 + lane * 4);
            u32x2 w; w.x = cvt_pk_bf16((v[j].x - mean) * rstd * (1.0f + sc.x) + sh.x, (v[j].y - mean) * rstd * (1.0f + sc.y) + sh.y);
            w.y = cvt_pk_bf16((v[j].z - mean) * rstd * (1.0f + sc.z) + sh.z, (v[j].w - mean) * rstd * (1.0f + sc.w) + sh.w);
            *(u32x2*)(H + (size_t)row * DM + j * 256 + lane * 4) = w;
            *(unsigned*)(ows(p) + WS_H8 + (size_t)row * DM + j * 256 + lane * 4) = pk4_fp8(bflo(w.x), bfhi(w.x), bflo(w.y), bfhi(w.y)); }
    }
}

__device__ __forceinline__ void lr_phase(const Params p, int l) {
    const int tid = otid(), wid = tid >> 6, lane = tid & 63, r = lane & 15, qd = lane >> 4;
    const bf16_t* H = (const bf16_t*)(ows(p) + WS_H); const bf16_t* bt = (const bf16_t*)(ows(p) + WS_BTIN) + ((size_t)l * RB + 3584) * 2048; float* LR = (float*)(ows(p) + WS_LR);
    for (int it = blockIdx.x * 8 + wid; it < T_ALL / 16; it += gridDim.x * 8) {
        const bf16_t* ap = H + (size_t)(it * 16 + r) * DM + qd * 8; const bf16_t* b0 = bt + (size_t)r * 2048 + qd * 8; const bf16_t* b1 = b0 + 16 * 2048;
        f32x4 c0 = {0.f, 0.f, 0.f, 0.f}, c1 = {0.f, 0.f, 0.f, 0.f};
#pragma unroll 8
        for (int ks = 0; ks < 64; ++ks) { const bf16x8 a = *(const bf16x8*)(ap + ks * 32); c0 = mfma16(a, *(const bf16x8*)(b0 + ks * 32), c0); c1 = mfma16(a, *(const bf16x8*)(b1 + ks * 32), c1); }
#pragma unroll
        for (int jj = 0; jj < 4; ++jj) { float* o = LR + (size_t)(it * 16 + qd * 4 + jj) * 32; o[r] = c0[jj]; o[16 + r] = c1[jj]; }
    }
}

template <bool F8> struct EpiInT {
    static constexpr bool PERM = true, AFTER_DRAIN = false, FP8 = F8;
    bf16_t* P; float* newk; int l;
    __device__ __forceinline__ void operator()(const f32x4 (&acc)[2][2][4][2], const Unit& u, int wr, int wc, int fr, int fq) const {
        const int j = u.pn;
        const int jb = F8 ? j - 50 : j;
        const int ptb = (jb < 4 ? 4 + jb : (jb < 6 ? 14 + (jb - 4) : 16 + (jb - 6)));
        const int pt = (F8 && j < 50) ? (j < 4 ? j : (j < 8 ? 8 + (j - 4) : (j < 10 ? 12 + (j - 8) : 20 + (j - 10)))) : ptb;
        const int row0 = u.pm * 256 + wr * 64 + fr, col0 = pt * 256 + wc * 32 + 8 * fq; const bool isk = !F8 && (j < 4) && (u.pm < 32);
        const float sc = F8 ? (1.0f / 64.0f) : 1.0f;
        const bool isz = F8 && (j < 50) && ((pt >= 8 && pt < 12) || (pt >= 20 && pt < 24) || (pt >= 32 && pt < 36));
        const int zseg = pt < 12 ? PZA : (pt < 24 ? PBZ : PCZ);
        const bool isg = F8 && (j < 50) && (pt >= 36);
#pragma unroll
        for (int ai = 0; ai < 2; ++ai)
#pragma unroll
            for (int m = 0; m < 4; ++m) { const int r = row0 + ai * 128 + m * 16;
#pragma unroll
                for (int bj = 0; bj < 2; ++bj) { const int c = col0 + bj * 128; const f32x4 v0 = acc[ai][bj][m][0] * sc, v1 = acc[ai][bj][m][1] * sc;
                    if (isz) { u32x2 w8; w8.x = pk4_fp8(v0[0], v0[1], v0[2], v0[3]); w8.y = pk4_fp8(v1[0], v1[1], v1[2], v1[3]); *(u32x2*)((unsigned char*)P + (size_t)r * NP * 2 + zseg * 2 + (c - zseg)) = w8; }
                    else if (isg) { u32x2 w8; w8.x = pk4_fp8(v0[0], v0[1], v0[2], v0[3]); w8.y = pk4_fp8(v1[0], v1[1], v1[2], v1[3]); *(u32x2*)((unsigned char*)P + (size_t)r * NP * 2 + PGA * 2 + (c - PGA)) = w8; }
                    else { u32x4 w; w.x = cvt_pk_bf16(v0[0], v0[1]); w.y = cvt_pk_bf16(v0[2], v0[3]); w.z = cvt_pk_bf16(v1[0], v1[1]); w.w = cvt_pk_bf16(v1[2], v1[3]);
                    *(u32x4*)(P + (size_t)r * NP + c) = w; }
                    if (isk) { float* d = newk + ((size_t)((r >> 8) * 2 + l) * 256 + (r & 255)) * 1024 + (c - 1024); *(f32x4*)d = v0; *(f32x4*)(d + 4) = v1; } } }
    }
};
struct In8Order {
    StaticOrder so; int G, c;
    __device__ bool next(int i, Unit& u) const { const int L = i * G + c; if (L < 2400) return so.next(i, u); const int L2 = L - 2400; if (L2 >= 160) return false; u.pm = 32 + L2 / 10; u.pn = 50 + L2 % 10; return true; }
    __device__ __forceinline__ void a_ready(const Unit&) const {}
    __device__ __forceinline__ void done(const Unit&) const {}
};
struct EpiV {
    static constexpr bool PERM = true, AFTER_DRAIN = false, FP8 = false;
    bf16_t* VT; float* newv; int l;
    __device__ __forceinline__ void operator()(const f32x4 (&acc)[2][2][4][2], const Unit& u, int wr, int wc, int fr, int fq) const {
        const int row0 = u.pm * 256 + wr * 64 + fr, col0 = u.pn * 256 + wc * 32 + 8 * fq; const bool isv = u.pn < 32;
#pragma unroll
        for (int ai = 0; ai < 2; ++ai)
#pragma unroll
            for (int m = 0; m < 4; ++m) { const int r = row0 + ai * 128 + m * 16;
#pragma unroll
                for (int bj = 0; bj < 2; ++bj) { const int c = col0 + bj * 128; const f32x4 v0 = acc[ai][bj][m][0], v1 = acc[ai][bj][m][1];
                    u32x4 w; w.x = cvt_pk_bf16(v0[0], v0[1]); w.y = cvt_pk_bf16(v0[2], v0[3]); w.z = cvt_pk_bf16(v1[0], v1[1]); w.w = cvt_pk_bf16(v1[2], v1[3]);
                    *(u32x4*)(VT + (size_t)r * T_ALL + c) = w;
                    if (isv) { float* d = newv + ((size_t)((c >> 8) * 2 + l) * 256 + (c & 255)) * 1024 + r;
#pragma unroll
                        for (int j = 0; j < 4; ++j) { d[(size_t)j * 1024] = v0[j]; d[(size_t)(j + 4) * 1024] = v1[j]; } } } }
    }
};
struct BrOrder {
    StaticOrder so;
    __device__ bool next(int i, Unit& u) const { Unit t; if (!so.next(i, t)) return false; u.pm = t.pm; u.pn = (t.pm / 48) * 8 + t.pn; return true; }
    __device__ __forceinline__ void a_ready(const Unit&) const {}
    __device__ __forceinline__ void done(const Unit&) const {}
};
struct EpiBr {
    static constexpr bool PERM = true, AFTER_DRAIN = false, FP8 = true;
    bf16_t* B01; bf16_t* B2;
    __device__ __forceinline__ void operator()(const f32x4 (&acc)[2][2][4][2], const Unit& u, int wr, int wc, int fr, int fq) const {
        const int br = u.pm / 48, pm = u.pm - br * 48, pn = u.pn - br * 8;
        const int row0 = pm * 256 + wr * 64 + fr, col0 = pn * 256 + wc * 32 + 8 * fq; unsigned char* O = (br == 2) ? (unsigned char*)B2 : (unsigned char*)B01 + (size_t)br * T_ALL * DM;
#pragma unroll
        for (int ai = 0; ai < 2; ++ai)
#pragma unroll
            for (int m = 0; m < 4; ++m) { const int r = row0 + ai * 128 + m * 16;
#pragma unroll
                for (int bj = 0; bj < 2; ++bj) { const int c = col0 + bj * 128; const f32x4 v0 = acc[ai][bj][m][0] * 0.25f, v1 = acc[ai][bj][m][1] * 0.25f;
                    u32x2 w; w.x = pk4_fp8(v0[0], v0[1], v0[2], v0[3]); w.y = pk4_fp8(v1[0], v1[1], v1[2], v1[3]);
                    *(u32x2*)(O + (size_t)r * DM + c) = w; } }
    }
};
__device__ __forceinline__ void merge_phase(const Params p) {
    const int tid = otid(), wid = tid >> 6, lane = tid & 63;
    const bf16_t* P = (const bf16_t*)(ows(p) + WS_P); const bf16_t* B01 = (const bf16_t*)(ows(p) + WS_OG); const bf16_t* B2 = (const bf16_t*)(ows(p) + WS_H); bf16_t* MRG = (bf16_t*)(ows(p) + WS_MRG);
    for (int row = blockIdx.x * 8 + wid; row < T_ALL; row += gridDim.x * 8) {
#pragma unroll
        for (int j = 0; j < 4; ++j) { const int c = j * 512 + lane * 8; float a[8];
#pragma unroll
            for (int i = 0; i < 8; ++i) a[i] = 0.f;
#pragma unroll
            for (int br = 0; br < 3; ++br) { const unsigned char* bp = (br == 2 ? (const unsigned char*)B2 : (const unsigned char*)B01 + (size_t)br * T_ALL * DM) + (size_t)row * DM + c;
                const u32x2 x = *(const u32x2*)bp; const u32x2 g8 = *(const u32x2*)((const unsigned char*)P + (size_t)row * NP * 2 + PGA * 2 + br * 2048 + c);
                typedef float f32x2m __attribute__((ext_vector_type(2)));
                const f32x2m x01 = __builtin_amdgcn_cvt_pk_f32_fp8((int)x.x, false), x23 = __builtin_amdgcn_cvt_pk_f32_fp8((int)x.x, true), x45 = __builtin_amdgcn_cvt_pk_f32_fp8((int)x.y, false), x67 = __builtin_amdgcn_cvt_pk_f32_fp8((int)x.y, true);
                const f32x2m g01 = __builtin_amdgcn_cvt_pk_f32_fp8((int)g8.x, false), g23 = __builtin_amdgcn_cvt_pk_f32_fp8((int)g8.x, true), g45 = __builtin_amdgcn_cvt_pk_f32_fp8((int)g8.y, false), g67 = __builtin_amdgcn_cvt_pk_f32_fp8((int)g8.y, true);
                a[0] += x01.x * sigmoidf_(g01.x); a[1] += x01.y * sigmoidf_(g01.y); a[2] += x23.x * sigmoidf_(g23.x); a[3] += x23.y * sigmoidf_(g23.y);
                a[4] += x45.x * sigmoidf_(g45.x); a[5] += x45.y * sigmoidf_(g45.y); a[6] += x67.x * sigmoidf_(g67.x); a[7] += x67.y * sigmoidf_(g67.y); }
            u32x2 w; w.x = pk4_fp8(a[0] * 0.0625f, a[1] * 0.0625f, a[2] * 0.0625f, a[3] * 0.0625f); w.y = pk4_fp8(a[4] * 0.0625f, a[5] * 0.0625f, a[6] * 0.0625f, a[7] * 0.0625f);
            *(u32x2*)((unsigned char*)MRG + (size_t)row * DM + c) = w; } }
}
struct EpiOut {
    static constexpr bool PERM = false, AFTER_DRAIN = false, FP8 = true;
    const float *xp, *xs, *x1; const float* mod; float* Z; int l;
    __device__ __forceinline__ void operator()(const f32x4 (&acc)[2][2][4][2], const Unit& u, int wr, int wc, int fr, int fq) const {
        const int row0 = u.pm * 256 + wr * 64 + fr, col0 = u.pn * 256 + wc * 32 + 4 * fq;
#pragma unroll
        for (int ai = 0; ai < 2; ++ai)
#pragma unroll
            for (int m = 0; m < 4; ++m) { const int r = row0 + ai * 128 + m * 16;
                const float* x = (l == 0) ? (r < T_CTX ? xp + (size_t)r * DM : xs + (size_t)(r - T_CTX) * DM) : x1 + (size_t)r * DM;
                const int vv = r < T_CTX ? 0 : 1 + ((r - T_CTX) >> 11); const float* gt = mod + (size_t)(l * 3 + vv) * 6144 + 4096;
#pragma unroll
                for (int bj = 0; bj < 2; ++bj)
#pragma unroll
                    for (int n = 0; n < 2; ++n) { const int c = col0 + bj * 128 + n * 16; const f32x4 xv = *(const f32x4*)(x + c), gv = *(const f32x4*)(gt + c);
                        *(f32x4*)(Z + (size_t)r * DM + c) = ALPHA_DN * xv + gv * (acc[ai][bj][m][n] * (1.0f / 64.0f)); } }
    }
};

template <bool WIN> __device__ __forceinline__ void att_half(const bf16x8 (&qf)[4], const bf16_t* Kb, size_t kstride, const bf16_t* Vtb, size_t vstride, int tb0, int tbs,
                                                            f32x4 (&o)[8], float& m, float& lsum, int r, int qd, const float* rpb_h, int drbase, int qc, int bs) {
    f32x4 sc[16];
#pragma unroll
    for (int k4 = 0; k4 < 4; ++k4) {
        bf16x8 kf[4][4];
#pragma unroll
        for (int t = 0; t < 4; ++t) { const int kt = k4 * 4 + t; const int tok = tb0 + (kt >> 1) * tbs + (kt & 1) * 16 + r; const bf16_t* kp = Kb + (size_t)tok * kstride + qd * 8;
#pragma unroll
            for (int ks = 0; ks < 4; ++ks) kf[t][ks] = *(const bf16x8*)(kp + ks * 32); }
        asm volatile("" : "+v"(kf[0][0]), "+v"(kf[0][1]), "+v"(kf[0][2]), "+v"(kf[0][3]), "+v"(kf[1][0]), "+v"(kf[1][1]), "+v"(kf[1][2]), "+v"(kf[1][3]));
        asm volatile("" : "+v"(kf[2][0]), "+v"(kf[2][1]), "+v"(kf[2][2]), "+v"(kf[2][3]), "+v"(kf[3][0]), "+v"(kf[3][1]), "+v"(kf[3][2]), "+v"(kf[3][3]));
#pragma unroll
        for (int t = 0; t < 4; ++t) { f32x4 a = {0.f, 0.f, 0.f, 0.f};
#pragma unroll
            for (int ks = 0; ks < 4; ++ks) a = mfma16(kf[t][ks], qf[ks], a);
            sc[k4 * 4 + t] = a; }
        __builtin_amdgcn_sched_barrier(0);
    }
    float mx = m;
    const int cs = min(max(qc - 8, 0), 48);
#pragma unroll
    for (int kt = 0; kt < 16; ++kt)
#pragma unroll
        for (int jj = 0; jj < 4; ++jj) { float v = sc[kt][jj] * ATT_SCALE;
            if (WIN) { const int kc = bs + (kt & 1) * 16 + qd * 4 + jj; const bool valid = (kc >= cs) && (kc < cs + 16); const int dci = min(max(kc - qc + 15, 0), 30);
                const float bias = rpb_h[(drbase + (kt >> 1)) * 31 + dci]; v = valid ? v + bias : -1e30f; }
            sc[kt][jj] = v; mx = fmaxf(mx, v); }
    mx = fmaxf(mx, sxor<16>(mx)); mx = fmaxf(mx, bperm(mx, ((qd * 16 + r) ^ 32) << 2));
    const float alpha = __expf(m - mx); m = mx; lsum *= alpha;
#pragma unroll
    for (int dt = 0; dt < 8; ++dt) o[dt] *= alpha;
    unsigned pk[16][2];
#pragma unroll
    for (int kt = 0; kt < 16; ++kt) { const float p0 = __expf(sc[kt][0] - mx), p1 = __expf(sc[kt][1] - mx), p2 = __expf(sc[kt][2] - mx), p3 = __expf(sc[kt][3] - mx);
        lsum += (p0 + p1) + (p2 + p3); pk[kt][0] = cvt_pk_bf16(p0, p1); pk[kt][1] = cvt_pk_bf16(p2, p3); }
#pragma unroll
    for (int g = 0; g < 8; ++g) { u32x4 bw; bw.x = pk[2 * g][0]; bw.y = pk[2 * g][1]; bw.z = pk[2 * g + 1][0]; bw.w = pk[2 * g + 1][1];
        const bf16x8 b = __builtin_bit_cast(bf16x8, bw);
        bf16x4 lo[8], hi[8];
#pragma unroll
        for (int dt = 0; dt < 8; ++dt) { const bf16_t* vp = Vtb + (size_t)(dt * 16 + r) * vstride + tb0 + g * tbs + qd * 4; lo[dt] = *(const bf16x4*)vp; hi[dt] = *(const bf16x4*)(vp + 16); }
#pragma unroll
        for (int dt = 0; dt < 8; ++dt) o[dt] = mfma16(__builtin_shufflevector(lo[dt], hi[dt], 0, 1, 2, 3, 4, 5, 6, 7), b, o[dt]);
        if (g & 1) __builtin_amdgcn_sched_barrier(0); }
}
__device__ __forceinline__ void att_wave(const Params p, int l, bool latent, int b, int h, int tokq0, int row, int t16) {
    const int lane = otid() & 63, r = lane & 15, qd = lane >> 4;
    const bf16_t* P = (const bf16_t*)(ows(p) + WS_P); const bf16_t* VT = (const bf16_t*)(ows(p) + WS_VT); bf16_t* YA = (bf16_t*)(ows(p) + WS_YCAT);
    bf16x8 qf[4];
    { const bf16_t* qp = P + (size_t)(tokq0 + r) * NP + PQ + h * 128 + qd * 8;
#pragma unroll
        for (int ks = 0; ks < 4; ++ks) qf[ks] = *(const bf16x8*)(qp + ks * 32); }
    f32x4 o[8];
#pragma unroll
    for (int dt = 0; dt < 8; ++dt) o[dt] = (f32x4){0.f, 0.f, 0.f, 0.f};
    float m = -1e30f, lsum = 0.f;
    if (!latent) {
        att_half<false>(qf, P + (size_t)(b * 256) * NP + PK + h * 128, NP, VT + (size_t)(h * 128) * T_ALL + b * 256, T_ALL, 0, 32, o, m, lsum, r, qd, nullptr, 0, 0, 0);
    } else {
        const int rs = min(max(row - 4, 0), 24), bs = min(max(16 * t16 - 8, 0), 32), tokb = T_CTX + b * 2048;
        att_half<true>(qf, P + (size_t)tokb * NP + PK + h * 128, NP, VT + (size_t)(h * 128) * T_ALL + tokb, T_ALL, rs * 64 + bs, 64, o, m, lsum, r, qd,
                       (const float*)(ows(p) + WS_SM) + SM_RPB + (size_t)(l * 8 + h) * 15 * 31, rs - row + 7, t16 * 16 + r, bs);
        att_half<false>(qf, (const bf16_t*)(ows(p) + WS_CK) + (size_t)((b * 2 + l) * 256) * 1024 + h * 128, 1024,
                        (const bf16_t*)(ows(p) + WS_CVT) + (size_t)((b * 2 + l) * 1024 + h * 128) * 256, 256, 0, 32, o, m, lsum, r, qd, nullptr, 0, 0, 0);
    }
    lsum += sxor<16>(lsum); lsum += bperm(lsum, (lane ^ 32) << 2);
#if defined(PROBE_ZERO_LAT)
    const float inv = latent ? 0.f : 1.0f / lsum;
#elif defined(PROBE_ZERO_CTX)
    const float inv = latent ? 1.0f / lsum : 0.f;
#else
    const float inv = 1.0f / lsum;
#endif
    const size_t tok = (size_t)(tokq0 + r);
#pragma unroll
    for (int dt = 0; dt < 8; ++dt) { const int dim = h * 128 + dt * 16 + qd * 4; const int z8 = *(const int*)((const unsigned char*)P + tok * NP * 2 + PZA * 2 + dim); typedef float f32x2z __attribute__((ext_vector_type(2))); const f32x2z z01 = __builtin_amdgcn_cvt_pk_f32_fp8(z8, false), z23 = __builtin_amdgcn_cvt_pk_f32_fp8(z8, true);
        *(unsigned*)((unsigned char*)YA + tok * 1024 + dim) = pk4_fp8(o[dt][0] * inv * siluf_(z01.x), o[dt][1] * inv * siluf_(z01.y), o[dt][2] * inv * siluf_(z23.x), o[dt][3] * inv * siluf_(z23.y)); }
}

constexpr int G_QE = 0, G_KE = 17408, G_KLT = 34816, G_BL = 53248, G_VT = 53760, G_ATT = 90624, G_WG = 99840, G_BG = 108032;
constexpr int G_IMG = 53760;
__device__ __forceinline__ size_t gla_unit(bool latent, int b, int h, int dir, int c) { return latent ? (size_t)(1024 + ((b * 4 + h) * 2 + dir) * 32 + c) : (size_t)(((b * 4 + h) * 2 + dir) * 4 + c); }
__device__ __forceinline__ void gla_stage(const Params p, int l, bool latent, int b, int h, int dir, int c0, LAS unsigned char* lds) {
    const int tid = otid(), w = tid >> 6, lane = tid & 63;
    const int L = latent ? 2048 : 256, tok0 = latent ? T_CTX + b * 2048 : b * 256;
    const bf16_t* P = (const bf16_t*)(ows(p) + WS_P); const float* LR = (const float*)(ows(p) + WS_LR);
    LAS bf16_t* QE = (LAS bf16_t*)(lds + G_QE); LAS bf16_t* KE = (LAS bf16_t*)(lds + G_KE); LAS bf16_t* KLT = (LAS bf16_t*)(lds + G_KLT);
    LAS float* WG = (LAS float*)(lds + G_WG); LAS float* BG = (LAS float*)(lds + G_BG); LAS float* BL = (LAS float*)(lds + G_BL);
    for (int i = tid; i < 2048; i += 512) WG[i] = ((const float*)(ows(p) + WS_SM) + SM_WG)[((size_t)(l * 2 + dir) * 16 + (i >> 7)) * 512 + h * 128 + (i & 127)];
    if (tid < 128) BG[tid] = ((const float*)(ows(p) + WS_SM) + SM_BGT)[(size_t)(l * 2 + dir) * 512 + h * 128 + tid];
    __syncthreads();
    const int d0 = w * 16;
    for (int c = c0; c < c0 + 4; ++c) {
        { const int pos = c * 64 + lane; const int tl = dir ? (L - 1 - pos) : pos; const size_t tok = (size_t)(tok0 + tl); const bf16_t* prow = P + tok * NP;
            float lr[16];
            { const float4* lp = (const float4*)(LR + tok * 32 + dir * 16);
#pragma unroll
              for (int i = 0; i < 4; ++i) { const float4 t4 = lp[i]; lr[4 * i] = t4.x; lr[4 * i + 1] = t4.y; lr[4 * i + 2] = t4.z; lr[4 * i + 3] = t4.w; } }
#pragma unroll
            for (int hf = 0; hf < 4; ++hf) { const int dd = d0 + hf * 4;
                float qv[4], kv[4];
                { const u32x2 a0 = *(const u32x2*)(prow + PBQ + h * 128 + dd), b0 = *(const u32x2*)(prow + PBK + h * 128 + dd);
                  qv[0] = bflo(a0.x); qv[1] = bfhi(a0.x); qv[2] = bflo(a0.y); qv[3] = bfhi(a0.y); kv[0] = bflo(b0.x); kv[1] = bfhi(b0.x); kv[2] = bflo(b0.y); kv[3] = bfhi(b0.y); }
                if (latent) {
                    const int dp = dd ^ 32; float qp[4], kp2[4];
                    { const u32x2 a0 = *(const u32x2*)(prow + PBQ + h * 128 + dp), b0 = *(const u32x2*)(prow + PBK + h * 128 + dp);
                      qp[0] = bflo(a0.x); qp[1] = bfhi(a0.x); qp[2] = bflo(a0.y); qp[3] = bfhi(a0.y); kp2[0] = bflo(b0.x); kp2[1] = bfhi(b0.x); kp2[2] = bflo(b0.y); kp2[3] = bfhi(b0.y); }
                    const float posf = (float)((dd < 64) ? (tl >> 6) : (tl & 63)); const bool second = (dd & 32) != 0; const int f0 = dd & 31;
#pragma unroll
                    for (int i = 0; i < 4; ++i) { const float inv = __expf(-(float)(2 * (f0 + i)) * (9.210340371976184f / 64.0f)); const float ang = posf * inv; float sn, cn; __sincosf(ang, &sn, &cn);
                        const float q1 = second ? qp[i] : qv[i], q2 = second ? qv[i] : qp[i], k1 = second ? kp2[i] : kv[i], k2 = second ? kv[i] : kp2[i];
                        qv[i] = second ? (q1 * sn + q2 * cn) : (q1 * cn - q2 * sn); kv[i] = second ? (k1 * sn + k2 * cn) : (k1 * cn - k2 * sn); }
                }
                unsigned qe[2], ke[2];
#pragma unroll
                for (int i = 0; i < 4; ++i) { float g = BG[dd + i];
#pragma unroll
                    for (int rr = 0; rr < 16; ++rr) g += lr[rr] * WG[rr * 128 + dd + i];
                    float la = -(fmaxf(-g, 0.f) + __logf(1.0f + __expf(-fabsf(g)))) * (1.0f / 16.0f);
#pragma unroll
                    for (int off = 1; off < 64; off <<= 1) { const float t_ = bperm(la, ((lane - off) & 63) << 2); if (lane >= off) la += t_; }
                    const float bl = rlane(la, 63);
                    const float eb = __expf(la), enb = __expf(-la), elb = __expf(bl - la);
                    const float qq = qv[i] * ATT_SCALE * eb, kk = kv[i] * enb, kl = kv[i] * elb;
                    if (i & 1) { qe[i >> 1] = cvt_pk_bf16(__uint_as_float(qe[i >> 1]), qq); ke[i >> 1] = cvt_pk_bf16(__uint_as_float(ke[i >> 1]), kk); }
                    else { qe[i >> 1] = __float_as_uint(qq); ke[i >> 1] = __float_as_uint(kk); }
                    if (lane == 63) BL[dd + i] = __expf(bl);
                    KLT[(dd + i) * 72 + lane] = f2bf(kl); }
                { u32x2 w0; w0.x = qe[0]; w0.y = qe[1]; *(LAS u32x2*)(QE + lane * 136 + dd) = w0; w0.x = ke[0]; w0.y = ke[1]; *(LAS u32x2*)(KE + lane * 136 + dd) = w0; }
            }
        }
        __syncthreads();
        { u32x4* dst = (u32x4*)(ows(p) + WS_GST + gla_unit(latent, b, h, dir, c) * G_IMG);
          for (int i = tid; i < G_IMG / 16; i += 512) dst[i] = *(const LAS u32x4*)(lds + i * 16); }
        __syncthreads();
    }
}
#define LDS_BARRIER() do { asm volatile("s_waitcnt lgkmcnt(0)" ::: "memory"); __builtin_amdgcn_s_barrier(); asm volatile("" ::: "memory"); } while (0)
template <int NS> __device__ __forceinline__ void gla_item(const Params p, int l, bool latent, int b, int h, int dir, int sl, LAS unsigned char* lds) {
    constexpr int X = 2 / NS, NV = 4 / NS; constexpr bool PFE = (NS == 2);
    const int tid = otid(), w = tid >> 6, lane = tid & 63, r = lane & 15, qd = lane >> 4;
    const int L = latent ? 2048 : 256, nch = L >> 6, tok0 = latent ? T_CTX + b * 2048 : b * 256;
    const bf16_t* P = (const bf16_t*)(ows(p) + WS_P); float* OG = (float*)(ows(p) + WS_OG) + (size_t)dir * T_ALL * 1024;
    LAS bf16_t* QE = (LAS bf16_t*)(lds + G_QE); LAS bf16_t* KE = (LAS bf16_t*)(lds + G_KE); LAS bf16_t* KLT = (LAS bf16_t*)(lds + G_KLT); LAS bf16_t* VTs = (LAS bf16_t*)(lds + G_VT);
    LAS bf16_t* ATT = (LAS bf16_t*)(lds + G_ATT); LAS float* BL = (LAS float*)(lds + G_BL);
    const int et0 = (NS == 1) ? 2 * w : sl * 8 + w;
    const int eb = (NS == 1) ? w * 32 : sl * 128 + w * 16;
    f32x4 S[X][8];
    const size_t sidx = ((((size_t)(b * 2 + l) * 2 + dir) * 4 + h) * 128 + qd * 4) * 256 + et0 * 16 + r;
#pragma unroll
    for (int x = 0; x < X; ++x)
#pragma unroll
        for (int dt = 0; dt < 8; ++dt)
#pragma unroll
            for (int jj = 0; jj < 4; ++jj) S[x][dt][jj] = latent ? ((const float*)(ows(p) + WS_SM) + SM_ST)[sidx + (size_t)(dt * 16 + jj) * 256 + x * 16] : 0.f;
    u32x4 pf[7], vpf[NV];
#define GLA_PF_LOAD(cc) do { const u32x4* srcp_ = (const u32x4*)(ows(p) + WS_GST + gla_unit(latent, b, h, dir, (cc)) * G_IMG); \
        _Pragma("unroll") for (int k_ = 0; k_ < 7; ++k_) { const int i_ = tid + k_ * 512; if (i_ < G_IMG / 16) pf[k_] = srcp_[i_]; } \
        const int pos_ = (cc) * 64 + lane; const int tl_ = dir ? (L - 1 - pos_) : pos_; const bf16_t* prow_ = P + (size_t)(tok0 + tl_) * NP + PBV + h * 256 + eb; \
        _Pragma("unroll") for (int k4_ = 0; k4_ < NV; ++k4_) vpf[k4_] = *(const u32x4*)(prow_ + k4_ * 8); } while (0)
#define GLA_PF_STORE() do { \
        _Pragma("unroll") for (int k_ = 0; k_ < 7; ++k_) { const int i_ = tid + k_ * 512; if (i_ < G_IMG / 16) *(LAS u32x4*)(lds + i_ * 16) = pf[k_]; } \
        _Pragma("unroll") for (int k4_ = 0; k4_ < NV; ++k4_) { const unsigned vw_[4] = {vpf[k4_].x, vpf[k4_].y, vpf[k4_].z, vpf[k4_].w}; \
            _Pragma("unroll") for (int i_ = 0; i_ < 4; ++i_) { VTs[(eb + k4_ * 8 + 2 * i_) * 72 + lane] = (bf16_t)(vw_[i_] & 0xffffu); VTs[(eb + k4_ * 8 + 2 * i_ + 1) * 72 + lane] = (bf16_t)(vw_[i_] >> 16); } } } while (0)
    if (PFE) GLA_PF_LOAD(0);
    for (int c = 0; c < nch; ++c) {
        if (!PFE) GLA_PF_LOAD(c);
        GLA_PF_STORE();
        LDS_BARRIER();
        if (PFE && c + 1 < nch) GLA_PF_LOAD(c + 1);
#pragma unroll
        for (int x = 0; x < 2; ++x) { const int id = 2 * w + x, it = id >> 2, jt = id & 3; f32x4 a = {0.f, 0.f, 0.f, 0.f};
#pragma unroll
            for (int ks = 0; ks < 4; ++ks) a = mfma16(*(const LAS bf16x8*)(QE + (it * 16 + r) * 136 + ks * 32 + qd * 8), *(const LAS bf16x8*)(KE + (jt * 16 + r) * 136 + ks * 32 + qd * 8), a);
#pragma unroll
            for (int jj = 0; jj < 4; ++jj) { const int i = it * 16 + qd * 4 + jj, j = jt * 16 + r; ATT[i * 72 + j] = f2bf((dir ? i > j : i >= j) ? a[jj] : 0.f); } }
        LDS_BARRIER();
#pragma unroll
        for (int x = 0; x < X; ++x) { const int et = et0 + x;
            bf16x8 sb[4];
#pragma unroll
            for (int dp = 0; dp < 4; ++dp) { u32x4 t; t.x = cvt_pk_bf16(S[x][2 * dp][0], S[x][2 * dp][1]); t.y = cvt_pk_bf16(S[x][2 * dp][2], S[x][2 * dp][3]);
                t.z = cvt_pk_bf16(S[x][2 * dp + 1][0], S[x][2 * dp + 1][1]); t.w = cvt_pk_bf16(S[x][2 * dp + 1][2], S[x][2 * dp + 1][3]); sb[dp] = __builtin_bit_cast(bf16x8, t); }
            const bf16x8 v0 = *(const LAS bf16x8*)(VTs + (et * 16 + r) * 72 + qd * 8), v1 = *(const LAS bf16x8*)(VTs + (et * 16 + r) * 72 + 32 + qd * 8);
#pragma unroll 1
            for (int it = 0; it < 4; ++it) { f32x4 a = {0.f, 0.f, 0.f, 0.f};
                a = mfma16(*(const LAS bf16x8*)(ATT + (it * 16 + r) * 72 + qd * 8), v0, a); a = mfma16(*(const LAS bf16x8*)(ATT + (it * 16 + r) * 72 + 32 + qd * 8), v1, a);
#pragma unroll
                for (int dp = 0; dp < 4; ++dp) { const LAS bf16_t* qp_ = QE + (it * 16 + r) * 136 + dp * 32 + qd * 4;
                    const bf16x4 lo = *(const LAS bf16x4*)qp_, hi = *(const LAS bf16x4*)(qp_ + 16);
                    a = mfma16(__builtin_shufflevector(lo, hi, 0, 1, 2, 3, 4, 5, 6, 7), sb[dp], a); }
#pragma unroll
                for (int jj = 0; jj < 4; ++jj) { const int pos = c * 64 + it * 16 + qd * 4 + jj; const int tl = dir ? (L - 1 - pos) : pos;
                    OG[(size_t)(tok0 + tl) * 1024 + h * 256 + et * 16 + r] = a[jj]; } }
#pragma unroll
            for (int dt = 0; dt < 8; ++dt) { const f32x4 dec = *(const LAS f32x4*)(BL + dt * 16 + qd * 4); f32x4 s = S[x][dt] * dec;
                s = mfma16(*(const LAS bf16x8*)(KLT + (dt * 16 + r) * 72 + qd * 8), v0, s); s = mfma16(*(const LAS bf16x8*)(KLT + (dt * 16 + r) * 72 + 32 + qd * 8), v1, s);
                S[x][dt] = s; if (dt & 1) __builtin_amdgcn_sched_barrier(0); } }
        LDS_BARRIER();
    }
#undef GLA_PF_LOAD
#undef GLA_PF_STORE
    if (!latent) { float* so = p.out + OUT_S;
#pragma unroll
        for (int x = 0; x < X; ++x)
#pragma unroll
            for (int dt = 0; dt < 8; ++dt)
#pragma unroll
                for (int jj = 0; jj < 4; ++jj) so[sidx + (size_t)(dt * 16 + jj) * 256 + x * 16] = S[x][dt][jj]; }
}

__device__ __forceinline__ void conv_item(const Params p, int l, int item, LAS unsigned char* lds) {
    const int tid = otid(), wid = tid >> 6, lane = tid & 63; const int R0 = item * 16;
    const int s0 = R0 < T_CTX ? (R0 & ~255) : T_CTX + ((R0 - T_CTX) & ~2047), s1 = s0 + (R0 < T_CTX ? 256 : 2048);
    const bf16_t* P = (const bf16_t*)(ows(p) + WS_P); unsigned char* YC = ows(p) + WS_YCAT + 2ull * T_ALL * 1024;
    LAS bf16_t* U = (LAS bf16_t*)lds;
    LAS float* RED = (LAS float*)(lds + 94208);
    LAS float* STAT = (LAS float*)(lds + 94208 + 1024);
#pragma unroll
    for (int kb = 0; kb < 3; ++kb) { u32x4 av[4], gv[4];
#pragma unroll
        for (int kk = 0; kk < 4; ++kk) { const int i = min(tid + (kb * 4 + kk) * 512, 46 * 128 - 1); const int s = i >> 7, c8 = (i & 127) * 8; const int row = min(max(R0 - 15 + s, s0), s1 - 1);
            av[kk] = *(const u32x4*)(P + (size_t)row * NP + PCU + c8); gv[kk] = *(const u32x4*)(P + (size_t)row * NP + PCG + c8); }
#pragma unroll
        for (int kk = 0; kk < 4; ++kk) { const int i = tid + (kb * 4 + kk) * 512; const int s = i >> 7, c8 = (i & 127) * 8; const int row = R0 - 15 + s; const u32x4 a = av[kk], g = gv[kk]; u32x4 w;
            w.x = cvt_pk_bf16(bflo(a.x) * sigmoidf_(bflo(g.x)), bfhi(a.x) * sigmoidf_(bfhi(g.x))); w.y = cvt_pk_bf16(bflo(a.y) * sigmoidf_(bflo(g.y)), bfhi(a.y) * sigmoidf_(bfhi(g.y)));
            w.z = cvt_pk_bf16(bflo(a.z) * sigmoidf_(bflo(g.z)), bfhi(a.z) * sigmoidf_(bfhi(g.z))); w.w = cvt_pk_bf16(bflo(a.w) * sigmoidf_(bflo(g.w)), bfhi(a.w) * sigmoidf_(bfhi(g.w)));
            if (!(row >= s0 && row < s1)) w = (u32x4){0u, 0u, 0u, 0u};
            if (i < 46 * 128) *(LAS u32x4*)(U + s * 1024 + c8) = w; } }
    const int ch = tid * 2;
    typedef float f32x2 __attribute__((ext_vector_type(2)));
    f32x2 wv2[31];
#pragma unroll
    for (int j = 0; j < 31; ++j) wv2[j] = *(const f32x2*)((const float*)(ows(p) + WS_SM) + SM_CW + ((size_t)l * 31 + j) * 1024 + ch);
    const f32x2 cb = *(const f32x2*)((const float*)(ows(p) + WS_SM) + SM_CB + (size_t)l * 1024 + ch);
    f32x2 a2[16];
#pragma unroll
    for (int t = 0; t < 16; ++t) a2[t] = cb;
    __syncthreads();
#pragma unroll
    for (int s = 0; s < 46; ++s) { const unsigned uu = *(const LAS unsigned*)(U + s * 1024 + ch); const f32x2 u2 = {bflo(uu), bfhi(uu)};
#pragma unroll
        for (int t = 0; t < 16; ++t) { const int j = s - t; if (j >= 0 && j <= 30) a2[t] = __builtin_elementwise_fma(u2, wv2[j], a2[t]); } }
    float a0[16], a1[16];
#pragma unroll
    for (int t = 0; t < 16; ++t) { a0[t] = a2[t].x; a1[t] = a2[t].y; }
#pragma unroll
    for (int t = 0; t < 16; ++t) { const float sm = wsum(a0[t] + a1[t]), sq = wsum(a0[t] * a0[t] + a1[t] * a1[t]); if (lane == 0) { RED[(wid * 16 + t) * 2] = sm; RED[(wid * 16 + t) * 2 + 1] = sq; } }
    __syncthreads();
    if (tid < 16) { float sm = 0.f, sq = 0.f;
#pragma unroll
        for (int ww = 0; ww < 8; ++ww) { sm += RED[(ww * 16 + tid) * 2]; sq += RED[(ww * 16 + tid) * 2 + 1]; }
        const float mean = sm * (1.0f / 1024.0f), var = fmaxf(sq * (1.0f / 1024.0f) - mean * mean, 0.f); STAT[tid * 2] = mean; STAT[tid * 2 + 1] = rsqrtf(var + 1e-5f); }
    __syncthreads();
    const float2 gn = *(const float2*)((const float*)(ows(p) + WS_SM) + SM_CNG + (size_t)l * 1024 + ch), bn = *(const float2*)((const float*)(ows(p) + WS_SM) + SM_CNB + (size_t)l * 1024 + ch);
#pragma unroll
    for (int t = 0; t < 16; ++t) { const float mean = STAT[t * 2], rstd = STAT[t * 2 + 1]; const size_t row = (size_t)(R0 + t);
        typedef float f32x2z __attribute__((ext_vector_type(2))); const f32x2z zc = __builtin_amdgcn_cvt_pk_f32_fp8((int)*(const unsigned short*)((const unsigned char*)P + row * NP * 2 + PCZ * 2 + ch), false);
        const float y0 = (a0[t] - mean) * rstd * gn.x + bn.x, y1 = (a1[t] - mean) * rstd * gn.y + bn.y;
        *(unsigned short*)(YC + row * 1024 + ch) = (unsigned short)(__builtin_amdgcn_cvt_pk_fp8_f32(siluf_(y0) * siluf_(zc.x), siluf_(y1) * siluf_(zc.y), 0, false) & 0xffff); }
}

__device__ __forceinline__ void gla_stage_phase(const Params p, int l, LAS unsigned char* lds, int ci) {
    const int tid = otid();
    int cix = ci; asm volatile("" : "+s"(cix)); unsigned* ctr = (unsigned*)(ows(p) + WS_CTL + (size_t)(CTL_Q * 4)) + cix; volatile LAS int* slot = (volatile LAS int*)(lds + LDS_CTL);
    for (;;) {
        __syncthreads();
        if (tid == 0) *slot = (int)atomicAdd(ctr, 1u);
        __syncthreads();
        const int a = *slot;
        if (a >= 128 + 256) break;
        if (a < 128) gla_stage(p, l, true, a >> 6, (a >> 4) & 3, (a >> 3) & 1, (a & 7) * 4, lds);
        else { const int q = a - 128; gla_stage(p, l, false, q >> 3, (q >> 1) & 3, q & 1, 0, lds); }
    }
}
__device__ __forceinline__ void mix_phase(const Params p, int l, LAS unsigned char* lds, int ci) {
    const int tid = otid(), w = tid >> 6;
    int cix = ci; asm volatile("" : "+s"(cix)); unsigned* ctr = (unsigned*)(ows(p) + WS_CTL + (size_t)(CTL_Q * 4)) + cix; volatile LAS int* slot = (volatile LAS int*)(lds + LDS_CTL);
    constexpr int N_GL = 32, N_AC = 512, N_NA = 256, N_GC = 512, N_CV = 768, N_ALL = N_GL + N_AC + N_NA + N_GC + N_CV;
    for (;;) {
        __syncthreads();
        if (tid == 0) *slot = (int)atomicAdd(ctr, 1u);
        __syncthreads();
        int a = *slot;
        if (a >= N_ALL) break;
#ifndef SK_GLA
        if (a < N_GL) { gla_item<2>(p, l, true, a >> 4, (a >> 2) & 3, (a >> 1) & 1, a & 1, lds);
#ifdef DBL_GLAL
            gla_item<2>(p, l, true, a >> 4, (a >> 2) & 3, (a >> 1) & 1, a & 1, lds);
#endif
            continue; }
#endif
        a -= N_GL;
#ifndef SK_ATT
        if (a < N_AC) { const int bh = a >> 1, half = a & 1, b = bh >> 3, h = bh & 7; att_wave(p, l, false, b, h, b * 256 + (half * 8 + w) * 16, 0, 0);
#ifdef DBL_ATT
            att_wave(p, l, false, b, h, b * 256 + (half * 8 + w) * 16, 0, 0);
#endif
            continue; }
        a -= N_AC;
        if (a < N_NA) { const int b = a >> 7, h = (a >> 4) & 7, row = (a & 15) * 2 + (w >> 2), t16 = w & 3; att_wave(p, l, true, b, h, T_CTX + b * 2048 + row * 64 + t16 * 16, row, t16);
#ifdef DBL_NA
            att_wave(p, l, true, b, h, T_CTX + b * 2048 + row * 64 + t16 * 16, row, t16);
#endif
            continue; }
#endif
        a -= N_NA;
#ifndef SK_GLA
        if (a < N_GC) { gla_item<2>(p, l, false, a >> 4, (a >> 2) & 3, (a >> 1) & 1, a & 1, lds);
#ifdef DBL_GLAC
            gla_item<2>(p, l, false, a >> 4, (a >> 2) & 3, (a >> 1) & 1, a & 1, lds);
#endif
            continue; }
#endif
        a -= N_GC;
#ifndef SK_CONV
        conv_item(p, l, a, lds);
#ifdef DBL_CONV
        __syncthreads();
        conv_item(p, l, a, lds);
#endif
#endif
    }
}

__device__ __forceinline__ void post_phase(const Params p, int l) {
    const int tid = otid(), wid = tid >> 6, lane = tid & 63;
    const bf16_t* P = (const bf16_t*)(ows(p) + WS_P); const float* OG = (const float*)(ows(p) + WS_OG); unsigned char* YB = ows(p) + WS_YCAT + 1ull * T_ALL * 1024;
    for (int tok = blockIdx.x * 8 + wid; tok < T_ALL; tok += gridDim.x * 8) { const bf16_t* prow = P + (size_t)tok * NP;
#pragma unroll
        for (int h = 0; h < 4; ++h) {
            const int e = h * 256 + lane * 4;
            const f32x4 of = *(const f32x4*)(OG + (size_t)tok * 1024 + e), ob = *(const f32x4*)(OG + (size_t)(T_ALL + tok) * 1024 + e);
            const int zb8 = *(const int*)((const unsigned char*)prow + PBZ * 2 + (e)); typedef float f32x2z __attribute__((ext_vector_type(2))); const f32x2z zb01 = __builtin_amdgcn_cvt_pk_f32_fp8(zb8, false), zb23 = __builtin_amdgcn_cvt_pk_f32_fp8(zb8, true);
            const f32x4 o = of + ob;
            const float rs = rsqrtf(wsum((o[0] * o[0] + o[1] * o[1]) + (o[2] * o[2] + o[3] * o[3])) * (1.0f / 256.0f) + 1e-5f);
            const f32x4 g = *(const f32x4*)((const float*)(ows(p) + WS_SM) + SM_NG + (size_t)l * 1024 + e);
            *(unsigned*)(YB + (size_t)tok * 1024 + e) = pk4_fp8(o[0] * rs * g[0] * siluf_(zb01.x), o[1] * rs * g[1] * siluf_(zb01.y), o[2] * rs * g[2] * siluf_(zb23.x), o[3] * rs * g[3] * siluf_(zb23.y)); } }
}


#define XB_TMO      128
#define XB_XCNT(j)  (256  + 64 * (j))
#define XB_XSUB(j)  (1280 + 64 * (j))
#define XB_XGEN(j)  (2304 + 64 * (j))
#define XB_TOP      3328
#define XB_TOPGEN   3392
#define XCD_BAR_WORDS 3456
#define XB_SPIN_CAP (1u << 18)

__device__ __forceinline__ unsigned xb_ld(unsigned* p)              { return __hip_atomic_load(p, __ATOMIC_RELAXED, __HIP_MEMORY_SCOPE_AGENT); }
__device__ __forceinline__ unsigned xb_add(unsigned* p, unsigned v) { return __hip_atomic_fetch_add(p, v, __ATOMIC_RELAXED, __HIP_MEMORY_SCOPE_AGENT); }
__device__ __forceinline__ unsigned xb_xcc_id() { return (unsigned)__builtin_amdgcn_readfirstlane((int)(__builtin_amdgcn_s_getreg((3 << 11) | 20) & 0xFu)); }
#define XB_SPIN(cond, bar) do { unsigned _sp = 0; while (cond) { __builtin_amdgcn_s_sleep(1); \
    if ((++_sp & 255u) == 0u) { if (xb_ld(&(bar)[XB_TMO])) break; if (_sp > XB_SPIN_CAP) { atomicAdd(&(bar)[XB_TMO], 1u); break; } } } } while (0)

struct XcdBarrier {
    unsigned* bar; unsigned x;
    volatile LAS unsigned* st;
};

__device__ __forceinline__ XcdBarrier xcd_barrier_post(unsigned* bar, volatile LAS unsigned* st) {
    XcdBarrier b; b.bar = bar; b.x = xb_xcc_id(); b.st = st;
    if (threadIdx.x == 0) (void)xb_add(&bar[XB_XCNT(b.x)], 1u);
    return b;
}
__device__ __forceinline__ void xcd_barrier_complete(unsigned* bar, unsigned x, unsigned& nloc, unsigned& nx) {
    const unsigned G = gridDim.x * gridDim.y * gridDim.z;
    unsigned sum, cnt, mine, sp = 0u;
    for (;;) {
        sum = 0u; cnt = 0u; mine = 0u;
#pragma unroll
        for (unsigned j = 0; j < 16; ++j) { const unsigned c = xb_ld(&bar[XB_XCNT(j)]); sum += c; cnt += (c > 0u) ? 1u : 0u; mine = (j == x) ? c : mine; }
        if (sum == G) break;
        __builtin_amdgcn_s_sleep(1);
        if ((++sp & 255u) == 0u) { if (xb_ld(&bar[XB_TMO])) break; if (sp > XB_SPIN_CAP) { atomicAdd(&bar[XB_TMO], 1u); break; } }
    }
    nloc = mine > 0u ? mine : 1u; nx = cnt > 0u ? cnt : 1u;
}

__device__ __forceinline__ void xcd_barrier(const XcdBarrier& b) {
    asm volatile("s_waitcnt vmcnt(0)" ::: "memory");
    __syncthreads();
    if (threadIdx.x == 0) {
        unsigned* bar = b.bar; const unsigned bx = xb_xcc_id();
        __builtin_amdgcn_s_waitcnt(0);
        unsigned nloc = b.st[0], nx = b.st[1];
        if (nloc == 0u) { xcd_barrier_complete(bar, bx, nloc, nx); b.st[0] = nloc; b.st[1] = nx; }
        const unsigned old = xb_add(&bar[XB_XSUB(bx)], 1u);
        const unsigned gen = old / nloc;
        if (old + 1u == (gen + 1u) * nloc) {
            __builtin_amdgcn_fence(__ATOMIC_RELEASE, "agent");
            asm volatile("s_waitcnt vmcnt(0)" ::: "memory");
            const unsigned og = xb_add(&bar[XB_TOP], 1u);
            const unsigned tg = og / nx;
            if (og + 1u == (tg + 1u) * nx) xb_add(&bar[XB_TOPGEN], 1u);
            else XB_SPIN(xb_ld(&bar[XB_TOPGEN]) == tg, bar);
            __builtin_amdgcn_fence(__ATOMIC_ACQUIRE, "agent");
            xb_add(&bar[XB_XGEN(bx)], 1u);
            asm volatile("s_waitcnt vmcnt(0)" ::: "memory");
        } else {
            XB_SPIN(xb_ld(&bar[XB_XGEN(bx)]) == gen, bar);
            __builtin_amdgcn_fence(__ATOMIC_ACQUIRE, "agent");
            asm volatile("s_waitcnt vmcnt(0)" ::: "memory");
        }
    }
    __syncthreads();
}

#ifdef DBL_SYNC
#define GRID_SYNC() do { xcd_barrier(xbar); xcd_barrier(xbar); } while (0)
#else
#define GRID_SYNC() xcd_barrier(xbar)
#endif
#define ws ows(p)
template <int LL> __device__ __forceinline__ void layer_body(const Params p, LAS unsigned char* lds, const XcdBarrier& xbar, const int c) {
    constexpr int l = LL;
#ifndef SK_LN
        if (l == 0) ln_phase<0>(p, 0); else ln_phase<1>(p, 1);
#ifdef DBL_LN
        if (l == 0) ln_phase<0>(p, 0);
#endif
#endif
        GRID_SYNC();
#ifndef SK_LR
        lr_phase(p, l);
#endif
#ifndef SK_IN
        { Gemm g; g.A = (const bf16_t*)(ws + WS_H); g.Bt = (const bf16_t*)(ws + WS_BTIN) + (size_t)l * RB * 2048; g.M = T_CTX; g.N = 2560; g.K = DM;
          StaticOrder so; so.init(T_CTX, 2560, gridDim.x, c);
          EpiInT<false> e; e.P = (bf16_t*)(ws + WS_P); e.newk = p.out + OUT_K; e.l = l;
          pg8::gemm_phase<EpiInT<false>, StaticOrder>(lds, g, so, e, nullptr); }
        { Gemm g; g.A = (const bf16_t*)(ws + WS_BTIN) + ((size_t)l * RB + 2560) * 2048; g.Bt = (const bf16_t*)(ws + WS_H); g.M = 1024; g.N = T_ALL; g.K = DM;
          StaticOrder so; so.init(1024, T_ALL, gridDim.x, (c + gridDim.x - 64) % gridDim.x);
          EpiV e; e.VT = (bf16_t*)(ws + WS_VT); e.newv = p.out + OUT_V; e.l = l;
          pg8::gemm_phase<EpiV, StaticOrder>(lds, g, so, e, nullptr); }
        { Gemm g; g.A = (const bf16_t*)(ws + WS_H8); g.Bt = (const bf16_t*)(ws + WS_BT8 + (size_t)l * R8 * 2048); g.M = T_ALL; g.N = R8; g.K = DM / 2;
          In8Order so; so.so.init(T_ALL, 12800, gridDim.x, c); so.G = gridDim.x; so.c = c;
          EpiInT<true> e; e.P = (bf16_t*)(ws + WS_P); e.newk = nullptr; e.l = l;
          pg8::gemm_phase<EpiInT<true>, In8Order>(lds, g, so, e, nullptr); }
#endif
        GRID_SYNC();
#ifndef SK_MIX
        gla_stage_phase(p, l, lds, 4 + l);
        GRID_SYNC();
        mix_phase(p, l, lds, l);
#ifdef DBL_MIX
        mix_phase(p, l, lds, 2 + l);
#endif
#endif
        GRID_SYNC();
#ifndef SK_POST
        post_phase(p, l);
#ifdef DBL_POST
        post_phase(p, l);
#endif
#endif
        GRID_SYNC();
#ifndef SK_BR
#ifdef DBL_BR
        for (int rep = 0; rep < 2; ++rep)
#endif
        { Gemm g; g.A = (const bf16_t*)(ws + WS_YCAT); g.Bt = (const bf16_t*)(ws + WS_BTBR + (size_t)l * 6144 * 1024); g.M = 3 * T_ALL; g.N = 3 * DM; g.K = 512;
          BrOrder bo; bo.so.init(3 * T_ALL, DM, gridDim.x, c);
          EpiBr e; e.B01 = (bf16_t*)(ws + WS_OG); e.B2 = (bf16_t*)(ws + WS_H);
          pg8::gemm_phase<EpiBr, BrOrder>(lds, g, bo, e, nullptr); }
        GRID_SYNC();
        merge_phase(p);
#endif
        GRID_SYNC();
        { Gemm g; g.A = (const bf16_t*)(ws + WS_MRG); g.Bt = (const bf16_t*)(ws + WS_BTOUT + (size_t)l * DM * DM); g.M = T_ALL; g.N = DM; g.K = DM / 2;
#ifndef SK_OUT
#ifdef DBL_OUT
          for (int rep = 0; rep < 2; ++rep) {
#else
          {
#endif
          StaticOrder so; so.init(T_ALL, DM, gridDim.x, c);
          EpiOut e; e.xp = p.x_prompt; e.xs = p.x_sample; e.x1 = (const float*)(ws + WS_X1); e.mod = (const float*)(ws + WS_MOD); e.Z = (float*)(ws + WS_P); e.l = l;
          pg8::gemm_phase<EpiOut, StaticOrder>(lds, g, so, e, nullptr); }
#endif
        }
        GRID_SYNC();
    }
#undef ws
__global__ void __launch_bounds__(512, 2) fwd_megakernel(Params p) {
    extern __shared__ __attribute__((aligned(16))) unsigned char smem[];
    LAS unsigned char* lds = (LAS unsigned char*)smem;
    cg::grid_group grid = cg::this_grid();
    const int c = blockIdx.x;
    if (threadIdx.x < 4) ((LAS unsigned*)(lds + LDS_CTL + 16))[threadIdx.x] = 0u;
    __syncthreads();
    const XcdBarrier xbar = xcd_barrier_post((unsigned*)(ows(p) + WS_CTL), (volatile LAS unsigned*)(lds + LDS_CTL + 16));
    if (p.out == nullptr) grid.sync();
    if (threadIdx.x == 0) { const unsigned x = xb_xcc_id(); const unsigned rk = atomicAdd((unsigned*)(ows(p) + WS_CTL) + CTL_Q + 16 + x, 1u);
        ((LAS unsigned*)(lds + LDS_CTL + 32))[0] = x; ((LAS unsigned*)(lds + LDS_CTL + 32))[1] = rk; }
#ifndef SK_P0
    phase0(p, lds);
#ifdef DBL_P0
    phase0(p, lds);
#endif
#endif
    GRID_SYNC();
    phase0b(p);
    GRID_SYNC();
    int ce = c;
    { unsigned* bar = (unsigned*)(ows(p) + WS_CTL); bool ok = (gridDim.x == 256);
#pragma unroll
      for (int j = 0; j < 16; ++j) ok = ok && (xb_ld(&bar[XB_XCNT(j)]) == (j < 8 ? 32u : 0u));
      const unsigned x = ((volatile LAS unsigned*)(lds + LDS_CTL + 32))[0], rk = ((volatile LAS unsigned*)(lds + LDS_CTL + 32))[1];
      if (ok && rk < 32u && x < 8u) ce = (int)(rk * 8u + x);
      ce = __builtin_amdgcn_readfirstlane(ce); }
    layer_body<0>(p, lds, xbar, ce);
    layer_body<1>(p, lds, xbar, ce);
    ln_phase<2>(p, 2);
}
}

extern "C" void kernel_launch(void* const* d_in, const int* in_sizes, int n_in, void* d_out, int out_size, void* d_ws, size_t ws_size, hipStream_t stream) {
    static int grid_blocks = 0;
    if (!grid_blocks) {
        int dev = 0, cus = 0, per_cu = 0;
        (void)hipGetDevice(&dev);
        (void)hipDeviceGetAttribute(&cus, hipDeviceAttributeMultiprocessorCount, dev);
        (void)hipFuncSetAttribute((const void*)mk::fwd_megakernel, hipFuncAttributeMaxDynamicSharedMemorySize, mk::LDS_BYTES);
        (void)hipOccupancyMaxActiveBlocksPerMultiprocessor(&per_cu, (const void*)mk::fwd_megakernel, 512, mk::LDS_BYTES);
        if (per_cu < 1) per_cu = 1;
        grid_blocks = cus * per_cu;
        if (ws_size < mk::WS_END || n_in != 24) fprintf(stderr, "kernel_launch: workspace %zu < %zu or n_in %d != 24\n", ws_size, (size_t)mk::WS_END, n_in);
    }
    (void)hipMemsetAsync(d_ws, 0, 16384, stream);
    mk::Params p{};
    const float** pp = (const float**)&p;
    for (int i = 0; i < 24; ++i) pp[i] = (const float*)d_in[i];
    p.out = (float*)d_out; p.ws = (unsigned char*)d_ws;
    void* args[] = {&p};
    hipError_t e = hipLaunchCooperativeKernel((void*)mk::fwd_megakernel, dim3(grid_blocks), dim3(512), args, mk::LDS_BYTES, stream);
    if (e != hipSuccess) fprintf(stderr, "cooperative launch failed: %s (grid %d)\n", hipGetErrorString(e), grid_blocks);
}
```
